# Optimizing an MI355X kernel written in HIP

```python
import jax, jax.numpy as jnp
from jax import lax
import numpy as np

D_MODEL = 1024
BATCH = 2
SEQ = 16384
DEPTH = 4

HEAD_DIM = 64
A_Q_HEADS = 8
A_KV_HEADS = 2
A_WINDOW = 128
B_GROUPS = ((128, 1), (512, 4), (2048, 16))
B_HEADS_PER_GROUP = 4
B_HEADS = B_HEADS_PER_GROUP * len(B_GROUPS)
N_ATTN_HEADS = A_Q_HEADS + B_HEADS
BLOCK = 128
A_Q_W = A_Q_HEADS * HEAD_DIM
A_KV_W = A_KV_HEADS * HEAD_DIM
B_W = B_HEADS * HEAD_DIM
B_OUT_W = B_HEADS_PER_GROUP * HEAD_DIM
IN_SPLITS = (A_Q_W, A_KV_W, A_KV_W, B_W, B_W, B_W, D_MODEL, D_MODEL)
IN_W = sum(IN_SPLITS)
D_FF = ((8 * D_MODEL + 3 * 256 - 1) // (3 * 256)) * 256
DN_ALPHA = (2 * DEPTH) ** 0.25
DN_BETA = (8 * DEPTH) ** -0.25
LN_EPS = 1e-5
NEG_INF = -1e30

kernel_name = "hybrid_swa_sink_dilated_gated_deepnorm"


def layer_norm(x, g, b):
    xf = x.astype(jnp.float32)
    mu = xf.mean(-1, keepdims=True)
    var = jnp.square(xf - mu).mean(-1, keepdims=True)
    y = (xf - mu) * lax.rsqrt(var + LN_EPS)
    return (y * g.astype(jnp.float32) + b.astype(jnp.float32)).astype(x.dtype)


def alibi_slopes(n):
    return jnp.exp2(-8.0 * jnp.arange(1, n + 1, dtype=jnp.float32) / n)


def banded_attention(q, k, v, slopes, max_dist, stride, sinks=None):
    bt, L, H, dh = q.shape
    hkv = k.shape[2]
    G = H // hkv
    nb = -(-L // BLOCK)
    Lp = nb * BLOCK
    q = jnp.pad(q, ((0, 0), (0, Lp - L), (0, 0), (0, 0)))
    kv_pad = ((0, 0), (BLOCK, Lp - L), (0, 0), (0, 0))
    k = jnp.pad(k, kv_pad).reshape(bt, nb + 1, BLOCK, hkv, dh)
    v = jnp.pad(v, kv_pad).reshape(bt, nb + 1, BLOCK, hkv, dh)
    kw = jnp.concatenate([k[:, :-1], k[:, 1:]], axis=2)
    vw = jnp.concatenate([v[:, :-1], v[:, 1:]], axis=2)
    qb = q.reshape(bt, nb, BLOCK, hkv, G, dh)
    s = jnp.einsum('bnqhgd,bnshd->bnhgqs', qb, kw,
                   preferred_element_type=jnp.float32) * (dh ** -0.5)
    qi = jnp.arange(BLOCK)[:, None]
    sj = jnp.arange(2 * BLOCK)[None, :]
    dist = qi + BLOCK - sj
    kpos = jnp.arange(nb)[:, None] * BLOCK + jnp.arange(2 * BLOCK)[None, :] - BLOCK
    valid = ((dist >= 0) & (dist <= max_dist))[None] & (kpos >= 0)[:, None, :]
    bias = -(slopes.astype(jnp.float32).reshape(hkv, G, 1, 1)
             * (dist * stride).astype(jnp.float32))
    s = jnp.where(valid[None, :, None, None], s + bias, NEG_INF)
    m = s.max(-1)
    if sinks is not None:
        sink = sinks.astype(jnp.float32).reshape(1, 1, hkv, G, 1)
        m = jnp.maximum(m, sink)
    e = jnp.exp(s - m[..., None])
    den = e.sum(-1)
    if sinks is not None:
        den = den + jnp.exp(sink - m)
    lse = m + jnp.log(den)
    p = (e / den[..., None]).astype(v.dtype)
    o = jnp.einsum('bnhgqs,bnshd->bnqhgd', p, vw).reshape(bt, Lp, H, dh)[:, :L]
    lse = lse.transpose(0, 1, 4, 2, 3).reshape(bt, Lp, H)[:, :L]
    return o, lse


def dilated_group(q, k, v, slopes, window, dilation):
    b, S, h, dh = q.shape
    n = S // dilation

    def fold(t):
        return t.reshape(b, n, dilation, h, dh).transpose(0, 2, 1, 3, 4).reshape(b * dilation, n, h, dh)

    o, lse = banded_attention(fold(q), fold(k), fold(v), slopes, window // dilation, dilation)
    o = o.reshape(b, dilation, n, h, dh).transpose(0, 2, 1, 3, 4).reshape(b, S, h, dh)
    lse = lse.reshape(b, dilation, n, h).transpose(0, 2, 1, 3).reshape(b, S, h)
    return o, lse


def token_mixer(u, w_in, sinks, w_a, w_b, w_o):
    b, S, _ = u.shape
    idx = list(np.cumsum(IN_SPLITS)[:-1])
    qa, ka, va, qb, kb, vb, ga, gb = jnp.split(u @ w_in, idx, axis=-1)
    slopes = alibi_slopes(N_ATTN_HEADS)
    ya, _ = banded_attention(qa.reshape(b, S, A_Q_HEADS, HEAD_DIM),
                             ka.reshape(b, S, A_KV_HEADS, HEAD_DIM),
                             va.reshape(b, S, A_KV_HEADS, HEAD_DIM),
                             slopes[:A_Q_HEADS], A_WINDOW - 1, 1, sinks)
    ya = ya.reshape(b, S, A_Q_W)
    gshape = (b, S, len(B_GROUPS), B_HEADS_PER_GROUP, HEAD_DIM)
    qb, kb, vb = qb.reshape(gshape), kb.reshape(gshape), vb.reshape(gshape)
    outs, lses = [], []
    for g, (window, dilation) in enumerate(B_GROUPS):
        lo = A_Q_HEADS + g * B_HEADS_PER_GROUP
        o, l = dilated_group(qb[:, :, g], kb[:, :, g], vb[:, :, g],
                             slopes[lo:lo + B_HEADS_PER_GROUP], window, dilation)
        outs.append(o)
        lses.append(l)
    wts = jax.nn.softmax(jnp.stack(lses), axis=0)
    yb = (jnp.stack(outs) * wts[..., None].astype(u.dtype)).sum(0).reshape(b, S, B_OUT_W)
    merged = jax.nn.sigmoid(ga) * (ya @ w_a) + jax.nn.sigmoid(gb) * (yb @ w_b)
    return merged @ w_o


def swiglu(u, w_gate, w_up, w_down):
    return (jax.nn.silu(u @ w_gate) * (u @ w_up)) @ w_down


def setup_inputs(seed: int = 0) -> dict:
    key = jax.random.key(seed)
    ks = jax.random.split(key, 20)
    nrm = lambda k, shape, s: jax.random.normal(k, shape, jnp.float32) * s
    L, D = DEPTH, D_MODEL
    return {
        "x": nrm(ks[0], (BATCH, SEQ, D), 1.0),
        "c": nrm(ks[1], (BATCH, D), 1.0),
        "w_ada": nrm(ks[2], (L, D, 6 * D), 0.5 * D ** -0.5),
        "b_ada": nrm(ks[3], (L, 6 * D), 0.02),
        "w_in": nrm(ks[4], (L, D, IN_W), D ** -0.5),
        "sinks": nrm(ks[5], (L, A_Q_HEADS), 0.5),
        "w_a": nrm(ks[6], (L, A_Q_W, D), A_Q_W ** -0.5),
        "w_b": nrm(ks[7], (L, B_OUT_W, D), B_OUT_W ** -0.5),
        "w_o": nrm(ks[8], (L, D, D), DN_BETA * D ** -0.5),
        "ln1_g": 1.0 + nrm(ks[9], (L, D), 0.02),
        "ln1_b": nrm(ks[10], (L, D), 0.02),
        "w_gate": nrm(ks[11], (L, D, D_FF), D ** -0.5),
        "w_up": nrm(ks[12], (L, D, D_FF), D ** -0.5),
        "w_down": nrm(ks[13], (L, D_FF, D), DN_BETA * D_FF ** -0.5),
        "ln2_g": 1.0 + nrm(ks[14], (L, D), 0.02),
        "ln2_b": nrm(ks[15], (L, D), 0.02),
    }


def reference(x, c, w_ada, b_ada, w_in, sinks, w_a, w_b, w_o, ln1_g, ln1_b,
              w_gate, w_up, w_down, ln2_g, ln2_b):
    sc = jax.nn.silu(c)
    for l in range(DEPTH):
        mod = (sc @ w_ada[l] + b_ada[l])[:, None, :]
        sh1, s1, g1, sh2, s2, g2 = jnp.split(mod, 6, axis=-1)
        u = x * (1 + s1) + sh1
        x = layer_norm(DN_ALPHA * x + g1 * token_mixer(u, w_in[l], sinks[l], w_a[l], w_b[l], w_o[l]),
                       ln1_g[l], ln1_b[l])
        u = x * (1 + s2) + sh2
        x = layer_norm(DN_ALPHA * x + g2 * swiglu(u, w_gate[l], w_up[l], w_down[l]),
                       ln2_g[l], ln2_b[l])
    return x
```

```cpp
#include <hip/hip_runtime.h>
#include <hip/hip_cooperative_groups.h>
#include <cstdio>
#include <cstdint>
namespace cg = cooperative_groups;

constexpr int BATCH = 2, SEQ = 16384, DM = 1024, DEPTH = 4, NTOK = BATCH * SEQ;
constexpr int INW = 5120, DFF = 2816, NGU = 2 * DFF;
constexpr int QA_OFF = 0, KA_OFF = 512, VA_OFF = 640, QB_OFF = 768, KB_OFF = 1536, VB_OFF = 2304, GA_OFF = 3072, GB_OFF = 4096;
constexpr float LN_EPS = 1e-5f;
constexpr float DN_ALPHA = 1.681792830507429f;
constexpr float LOG2E = 1.4426950408889634f;
constexpr float QSCALE = 0.125f * LOG2E;

namespace pg8 {
#define PG8_LAS __attribute__((address_space(3)))
typedef unsigned short bf16_t;
typedef short bf16x8 __attribute__((ext_vector_type(8)));
typedef float f32x4 __attribute__((ext_vector_type(4)));
typedef unsigned u32x4 __attribute__((ext_vector_type(4)));
constexpr int BM = 256, BK = 64, HALF = 128, HTB = HALF * BK * 2  , STAGE_BYTES = 8 * HTB, NXCD = 8, WGM = 8;

__host__ __device__ __forceinline__ int lds_byte(int r, int c) { const int st = (r >> 4) * 2 + (c >> 5), rr = r & 15, cc = c & 31, ob = rr * 64 + cc * 2; return st * 1024 + (ob ^ (((ob >> 9) & 1) << 5)); }
__host__ __device__ __forceinline__ void stage_rc(int b, int& R, int& C) { const int st = b / 1024, sb = b % 1024, swz = sb ^ (((sb >> 9) & 1) << 5); R = (st >> 1) * 16 + swz / 64; C = (st & 1) * 32 + (swz % 64) / 2; }
__host__ __device__ __forceinline__ int perm32(int rho) { const int n = rho >> 4, i = rho & 15; return 8 * (i >> 2) + 4 * n + (i & 3); }

struct Unit { int pm, pn; };
struct Gemm { const bf16_t* A; const bf16_t* Bt; int M, N, K; };

struct StaticOrder {
    int nM, nN, nwg, G, c;
    __host__ __device__ void init(int M, int N, int G_, int c_) { nM = M / BM; nN = N / BM; nwg = nM * nN; G = G_; c = c_; }
    __host__ __device__ bool next(int i, Unit& u) const {
        const long L = (long)i * G + c; if (L >= nwg) return false;
        int wgid = (int)L; { const int q = nwg / NXCD, r = nwg % NXCD, xcd = wgid % NXCD, off = wgid / NXCD; wgid = (xcd < r ? xcd * (q + 1) : r * (q + 1) + (xcd - r) * q) + off; }
        const int nig = WGM * nN, gid = wgid / nig, fm = gid * WGM, gsz = (nM - fm) < WGM ? (nM - fm) : WGM;
        u.pm = fm + ((wgid % nig) % gsz); u.pn = (wgid % nig) / gsz; return true;
    }
    __device__ __forceinline__ void a_ready(const Unit&) const {}
    __device__ __forceinline__ void done(const Unit&) const {}
};

__device__ __forceinline__ unsigned cvt_pk_bf16(float lo, float hi) { unsigned r; asm volatile("v_cvt_pk_bf16_f32 %0, %1, %2" : "=v"(r) : "v"(lo), "v"(hi)); return r; }
__device__ __forceinline__ float bf_lo(unsigned w) { return __uint_as_float(w << 16); }
__device__ __forceinline__ float bf_hi(unsigned w) { return __uint_as_float(w & 0xffff0000u); }
__device__ __forceinline__ float fast_sigmoid(float v) { return __builtin_amdgcn_rcpf(1.0f + __builtin_amdgcn_exp2f(-v * 1.4426950408889634f)); }

struct EpiIn {
    static constexpr bool PERM = true, AFTER_DRAIN = false;
    bf16_t* O; float qscale;
    __device__ __forceinline__ void operator()(const f32x4 (&acc)[2][2][4][2], const Unit& u, int wr, int wc, int fr, int fq) const {
        const int row0 = u.pm * BM + wr * 64 + fr, col0 = u.pn * BM + wc * 32 + 8 * fq;
        const int mode = (u.pn <= 1 || (u.pn >= 3 && u.pn <= 5)) ? 1 : (u.pn >= 12 ? 2 : 0);
#pragma unroll
        for (int ai = 0; ai < 2; ++ai)
#pragma unroll
            for (int m = 0; m < 4; ++m) { bf16_t* rowp = O + (size_t)(row0 + ai * HALF + m * 16) * 5120 + col0;
#pragma unroll
                for (int bj = 0; bj < 2; ++bj) { f32x4 v0 = acc[ai][bj][m][0], v1 = acc[ai][bj][m][1];
                    if (mode == 1) { v0 = v0 * qscale; v1 = v1 * qscale; }
                    else if (mode == 2) {
#pragma unroll
                        for (int e = 0; e < 4; ++e) { v0[e] = fast_sigmoid(v0[e]); v1[e] = fast_sigmoid(v1[e]); } }
                    u32x4 w; w.x = cvt_pk_bf16(v0[0], v0[1]); w.y = cvt_pk_bf16(v0[2], v0[3]); w.z = cvt_pk_bf16(v1[0], v1[1]); w.w = cvt_pk_bf16(v1[2], v1[3]);
                    *(u32x4*)(rowp + bj * HALF) = w; } }
    }
};
template <bool ACCUM> struct EpiGate {
    static constexpr bool PERM = true, AFTER_DRAIN = false;
    bf16_t* O; const bf16_t* G; int goff;
    __device__ __forceinline__ void operator()(const f32x4 (&acc)[2][2][4][2], const Unit& u, int wr, int wc, int fr, int fq) const {
        const int row0 = u.pm * BM + wr * 64 + fr, col0 = u.pn * BM + wc * 32 + 8 * fq;
#pragma unroll
        for (int ai = 0; ai < 2; ++ai)
#pragma unroll
            for (int m = 0; m < 4; ++m) { const size_t row = (size_t)(row0 + ai * HALF + m * 16); bf16_t* rowp = O + row * 1024 + col0; const bf16_t* gp = G + row * 5120 + goff + col0;
#pragma unroll
                for (int bj = 0; bj < 2; ++bj) { const f32x4 v0 = acc[ai][bj][m][0], v1 = acc[ai][bj][m][1];
                    const u32x4 g = *(const u32x4*)(gp + bj * HALF);
                    float o[8];
                    o[0] = bf_lo(g.x) * v0[0]; o[1] = bf_hi(g.x) * v0[1]; o[2] = bf_lo(g.y) * v0[2]; o[3] = bf_hi(g.y) * v0[3];
                    o[4] = bf_lo(g.z) * v1[0]; o[5] = bf_hi(g.z) * v1[1]; o[6] = bf_lo(g.w) * v1[2]; o[7] = bf_hi(g.w) * v1[3];
                    if (ACCUM) { const u32x4 p = *(const u32x4*)(rowp + bj * HALF);
                        o[0] += bf_lo(p.x); o[1] += bf_hi(p.x); o[2] += bf_lo(p.y); o[3] += bf_hi(p.y); o[4] += bf_lo(p.z); o[5] += bf_hi(p.z); o[6] += bf_lo(p.w); o[7] += bf_hi(p.w); }
                    u32x4 w; w.x = cvt_pk_bf16(o[0], o[1]); w.y = cvt_pk_bf16(o[2], o[3]); w.z = cvt_pk_bf16(o[4], o[5]); w.w = cvt_pk_bf16(o[6], o[7]);
                    *(u32x4*)(rowp + bj * HALF) = w; }
                asm volatile("" ::: "memory"); }
    }
};
struct EpiRes {
    static constexpr bool PERM = false, AFTER_DRAIN = false;
    const float* xres; float* z; const float* gmod0; const float* gmod1; float alpha;
    __device__ __forceinline__ void operator()(const f32x4 (&acc)[2][2][4][2], const Unit& u, int wr, int wc, int fr, int fq) const {
        const int row0 = u.pm * BM + wr * 64 + fr, col0 = u.pn * BM + wc * 32 + 4 * fq;
        const float* gm = (u.pm < 64) ? gmod0 : gmod1;
        f32x4 gv[2][2];
#pragma unroll
        for (int bj = 0; bj < 2; ++bj)
#pragma unroll
            for (int n = 0; n < 2; ++n) gv[bj][n] = *(const f32x4*)(gm + col0 + bj * HALF + n * 16);
#pragma unroll
        for (int ai = 0; ai < 2; ++ai)
#pragma unroll
            for (int m = 0; m < 4; ++m) { const size_t off = (size_t)(row0 + ai * HALF + m * 16) * 1024 + col0;
#pragma unroll
                for (int bj = 0; bj < 2; ++bj)
#pragma unroll
                    for (int n = 0; n < 2; ++n) { const f32x4 xv = *(const f32x4*)(xres + off + bj * HALF + n * 16);
                        *(f32x4*)(z + off + bj * HALF + n * 16) = xv * alpha + gv[bj][n] * acc[ai][bj][m][n]; } }
    }
};
struct EpiSwiGLU {
    static constexpr bool PERM = true, AFTER_DRAIN = false;
    bf16_t* O;
    __device__ __forceinline__ void operator()(const f32x4 (&acc)[2][2][4][2], const Unit& u, int wr, int wc, int fr, int fq) const {
        const int row0 = u.pm * BM + wr * 64 + fr, col0 = u.pn * HALF + wc * 32 + 8 * fq;
#pragma unroll
        for (int ai = 0; ai < 2; ++ai)
#pragma unroll
            for (int m = 0; m < 4; ++m) { bf16_t* rowp = O + (size_t)(row0 + ai * HALF + m * 16) * 2816 + col0;
                float o[8];
#pragma unroll
                for (int n = 0; n < 2; ++n)
#pragma unroll
                    for (int e = 0; e < 4; ++e) { const float g = acc[ai][0][m][n][e], up = acc[ai][1][m][n][e]; o[4 * n + e] = g * fast_sigmoid(g) * up; }
                u32x4 w; w.x = cvt_pk_bf16(o[0], o[1]); w.y = cvt_pk_bf16(o[2], o[3]); w.z = cvt_pk_bf16(o[4], o[5]); w.w = cvt_pk_bf16(o[6], o[7]);
                *(u32x4*)(rowp) = w; }
    }
};

template <class Epi, class Sched, bool ALIGN_EPI = false, bool SP2 = false>
__device__ __forceinline__ void gemm_phase(PG8_LAS unsigned char* lds, const Gemm g, const Sched& S, const Epi& E) {
    int tid_ = threadIdx.x; asm volatile("" : "+v"(tid_)); const int tid = tid_, wid = __builtin_amdgcn_readfirstlane(tid >> 6), lane = tid & 63, wr = wid >> 2, wc = wid & 3, fr = lane & 15, fq = lane >> 4;
    const int K = g.K, nt = K / BK;
    unsigned voffA[2], voffB[2];
#pragma unroll
    for (int i = 0; i < 2; ++i) { int R, C; stage_rc(tid * 16 + i * 8192, R, C); const int Rb = Epi::PERM ? ((R & ~31) + perm32(R & 31)) : R;
        voffA[i] = (unsigned)(R * K + C) * 2u; voffB[i] = (unsigned)(Rb * K + C) * 2u; }
    const size_t kstep = (size_t)(BK * 2);
    const size_t hstep = (size_t)HALF * K * 2;
    const size_t tstep = 2 * hstep;
    const unsigned ldsw = (unsigned)wid * 1024u;
    const int aoff = lds_byte(wr * 64 + fr, fq * 8), boff = lds_byte(wc * 32 + fr, fq * 8);
#define PG8_SA(b, h) (((b) * 2 + (h)) * HTB)
#define PG8_SB(b, h) ((4 + (b) * 2 + (h)) * HTB)
#define PG8_STAGE(bufoff, gbase, voff) do { _Pragma("unroll") for (int _i = 0; _i < 2; ++_i) \
        __builtin_amdgcn_global_load_lds((const unsigned*)((const char*)(gbase) + (voff)[_i]), (PG8_LAS unsigned*)(lds + (bufoff) + ldsw + _i * 8192), 16, 0, 0); } while (0)
#define PG8_LDA(dst, b, h) do { _Pragma("unroll") for (int m = 0; m < 4; ++m) _Pragma("unroll") for (int k = 0; k < 2; ++k) dst[m][k] = *(const PG8_LAS bf16x8*)(lds + PG8_SA(b, h) + aoff + m * 2048 + k * 1024); } while (0)
#define PG8_LDB(dst, b, h) do { _Pragma("unroll") for (int n = 0; n < 2; ++n) _Pragma("unroll") for (int k = 0; k < 2; ++k) dst[n][k] = *(const PG8_LAS bf16x8*)(lds + PG8_SB(b, h) + boff + n * 2048 + k * 1024); } while (0)
#define PG8_MMA(ai, bj, At, Bt) do { __builtin_amdgcn_s_setprio(1); _Pragma("unroll") for (int m = 0; m < 4; ++m) _Pragma("unroll") for (int n = 0; n < 2; ++n) _Pragma("unroll") for (int k = 0; k < 2; ++k) \
        acc[ai][bj][m][n] = __builtin_amdgcn_mfma_f32_16x16x32_bf16(Bt[n][k], At[m][k], acc[ai][bj][m][n], 0, 0, 0); __builtin_amdgcn_s_setprio(0); } while (0)
#define PG8_WAIT_V(n) asm volatile("s_waitcnt vmcnt(" #n ")" ::: "memory")
#define PG8_WAIT_L(n) asm volatile("s_waitcnt lgkmcnt(" #n ")" ::: "memory")
#define PG8_BAR __builtin_amdgcn_s_barrier()
#define PG8_SCHED __builtin_amdgcn_sched_barrier(0)
    Unit cur, nxt; int ui = 0;
    if (!S.next(0, cur)) return;
    f32x4 acc[2][2][4][2];
#pragma unroll
    for (int a = 0; a < 2; ++a)
#pragma unroll
        for (int b = 0; b < 2; ++b)
#pragma unroll
            for (int m = 0; m < 4; ++m)
#pragma unroll
                for (int n = 0; n < 2; ++n) acc[a][b][m][n] = (f32x4){0.f, 0.f, 0.f, 0.f};
    bf16x8 At[4][2], B0[2][2], B1[2][2];
    const char* cA = (const char*)g.A + (size_t)cur.pm * tstep; const char* cB = (const char*)g.Bt + (size_t)cur.pn * tstep;
    S.a_ready(cur);
    if constexpr (SP2) {
        PG8_STAGE(PG8_SB(0, 0), cB, voffB); PG8_STAGE(PG8_SB(0, 1), cB + hstep, voffB); PG8_STAGE(PG8_SA(0, 0), cA, voffA); PG8_STAGE(PG8_SA(0, 1), cA + hstep, voffA);
        if (wr == 1) PG8_BAR;
        PG8_WAIT_V(2); PG8_BAR;
        PG8_STAGE(PG8_SB(1, 0), cB + kstep, voffB); PG8_STAGE(PG8_SA(1, 0), cA + kstep, voffA); PG8_STAGE(PG8_SB(1, 1), cB + hstep + kstep, voffB);
        PG8_WAIT_V(6); PG8_BAR;
    } else {
        PG8_STAGE(PG8_SB(0, 0), cB, voffB); PG8_STAGE(PG8_SA(0, 0), cA, voffA); PG8_STAGE(PG8_SB(0, 1), cB + hstep, voffB); PG8_STAGE(PG8_SA(0, 1), cA + hstep, voffA);
        if (wr == 1) PG8_BAR;
        PG8_WAIT_V(4); PG8_BAR;
        PG8_STAGE(PG8_SB(1, 0), cB + kstep, voffB); PG8_STAGE(PG8_SA(1, 0), cA + kstep, voffA); PG8_STAGE(PG8_SB(1, 1), cB + hstep + kstep, voffB);
        PG8_WAIT_V(6); PG8_BAR;
    }
    for (;;) {
        const bool has_next = S.next(ui + 1, nxt);
        const char* nA = has_next ? (const char*)g.A + (size_t)nxt.pm * tstep : cA; const char* nB = has_next ? (const char*)g.Bt + (size_t)nxt.pn * tstep : cB;
        for (int t = 0; t < nt; t += 2) {
            const bool last = (t == nt - 2);
            const char* a1 = cA + (size_t)(t + 1) * kstep;
            const char* a2 = last ? nA : cA + (size_t)(t + 2) * kstep; const char* b2 = last ? nB : cB + (size_t)(t + 2) * kstep;
            const char* a3 = a2 + kstep; const char* b3 = b2 + kstep;
            if (last && has_next) S.a_ready(nxt);
            if constexpr (SP2) {
            PG8_LDB(B0, 0, 0); PG8_LDB(B1, 0, 1); PG8_SCHED; PG8_LDA(At, 0, 0); PG8_STAGE(PG8_SA(1, 1), a1 + hstep, voffA);
            PG8_WAIT_V(8); PG8_WAIT_L(0); PG8_BAR; PG8_MMA(0, 0, At, B0); PG8_MMA(0, 1, At, B1); PG8_BAR; PG8_SCHED;
            PG8_LDA(At, 0, 1); PG8_STAGE(PG8_SB(0, 0), b2, voffB); PG8_STAGE(PG8_SB(0, 1), b2 + hstep, voffB); PG8_STAGE(PG8_SA(0, 0), a2, voffA);
            PG8_WAIT_V(8); PG8_WAIT_L(0); PG8_BAR; PG8_MMA(1, 0, At, B0); PG8_MMA(1, 1, At, B1); PG8_BAR; PG8_SCHED;
            PG8_LDB(B0, 1, 0); PG8_LDB(B1, 1, 1); PG8_SCHED; PG8_LDA(At, 1, 0); PG8_STAGE(PG8_SA(0, 1), a2 + hstep, voffA);
            PG8_WAIT_V(8); PG8_WAIT_L(0); PG8_BAR; PG8_MMA(0, 0, At, B0); PG8_MMA(0, 1, At, B1); PG8_BAR; PG8_SCHED;
            PG8_LDA(At, 1, 1); PG8_STAGE(PG8_SB(1, 0), b3, voffB); PG8_STAGE(PG8_SB(1, 1), b3 + hstep, voffB); PG8_STAGE(PG8_SA(1, 0), a3, voffA);
            PG8_WAIT_V(8); PG8_WAIT_L(0); PG8_BAR; PG8_MMA(1, 0, At, B0); PG8_MMA(1, 1, At, B1); PG8_BAR; PG8_SCHED;
            } else {
            PG8_LDB(B0, 0, 0); PG8_SCHED; PG8_LDA(At, 0, 0); PG8_STAGE(PG8_SA(1, 1), a1 + hstep, voffA);
            PG8_WAIT_L(8); PG8_BAR; PG8_WAIT_L(0); PG8_MMA(0, 0, At, B0); PG8_BAR; PG8_SCHED;
            PG8_LDB(B1, 0, 1); PG8_STAGE(PG8_SB(0, 0), b2, voffB);
            PG8_BAR; PG8_WAIT_L(0); PG8_MMA(0, 1, At, B1); PG8_BAR;
            PG8_LDA(At, 0, 1); PG8_STAGE(PG8_SA(0, 0), a2, voffA);
            PG8_BAR; PG8_WAIT_L(0); PG8_MMA(1, 0, At, B0); PG8_BAR; PG8_SCHED;
            PG8_STAGE(PG8_SB(0, 1), b2 + hstep, voffB);
            PG8_WAIT_V(6); PG8_BAR; PG8_MMA(1, 1, At, B1); PG8_BAR;
            PG8_LDB(B0, 1, 0); PG8_SCHED; PG8_LDA(At, 1, 0); PG8_STAGE(PG8_SA(0, 1), a2 + hstep, voffA);
            PG8_WAIT_L(8); PG8_BAR; PG8_WAIT_L(0); PG8_MMA(0, 0, At, B0); PG8_BAR; PG8_SCHED;
            PG8_LDB(B1, 1, 1); PG8_STAGE(PG8_SB(1, 0), b3, voffB);
            PG8_BAR; PG8_WAIT_L(0); PG8_MMA(0, 1, At, B1); PG8_BAR;
            PG8_LDA(At, 1, 1); PG8_STAGE(PG8_SA(1, 0), a3, voffA);
            PG8_BAR; PG8_WAIT_L(0); PG8_MMA(1, 0, At, B0); PG8_BAR; PG8_SCHED;
            PG8_STAGE(PG8_SB(1, 1), b3 + hstep, voffB);
            PG8_WAIT_V(6); PG8_BAR; PG8_MMA(1, 1, At, B1); PG8_BAR;
            }
        }
        if constexpr (ALIGN_EPI) { if (wr == 0) PG8_BAR; }
        if constexpr (!Epi::AFTER_DRAIN) { E(acc, cur, wr, wc, fr, fq); S.done(cur); }
        if (!has_next) break;
#pragma unroll
        for (int a = 0; a < 2; ++a)
#pragma unroll
            for (int b = 0; b < 2; ++b)
#pragma unroll
                for (int m = 0; m < 4; ++m)
#pragma unroll
                    for (int n = 0; n < 2; ++n) acc[a][b][m][n] = (f32x4){0.f, 0.f, 0.f, 0.f};
        cur = nxt; cA = nA; cB = nB; ++ui;
        if constexpr (ALIGN_EPI) { if (wr == 1) PG8_BAR; }
    }
    PG8_WAIT_V(0);
    if constexpr (!ALIGN_EPI) { if (wr == 0) PG8_BAR; }
    PG8_BAR;
    if constexpr (Epi::AFTER_DRAIN) { E.fused(acc, cur, wr, wc, fr, fq, lds, wid, lane); S.done(cur); }
#undef PG8_SA
#undef PG8_SB
#undef PG8_STAGE
#undef PG8_LDA
#undef PG8_LDB
#undef PG8_MMA
#undef PG8_WAIT_V
#undef PG8_WAIT_L
#undef PG8_BAR
#undef PG8_SCHED
}
}

#define LAS __attribute__((address_space(3)))
typedef unsigned short bf16;
typedef unsigned v4u __attribute__((ext_vector_type(4)));
typedef unsigned v2u __attribute__((ext_vector_type(2)));
typedef float f32x4 __attribute__((ext_vector_type(4)));
typedef float f32x16 __attribute__((ext_vector_type(16)));
typedef short bf16x8 __attribute__((ext_vector_type(8)));
typedef short v4i16_t __attribute__((ext_vector_type(4)));
using pg8::cvt_pk_bf16; using pg8::bf_lo; using pg8::bf_hi;

constexpr int NWAVES = 8, NTHREADS = 512;
constexpr int LDS_BYTES = 147456;
constexpr size_t MiB = 1u << 20;
constexpr size_t WS_MOD = 0;
constexpr size_t WS_LSE = 1 * MiB;
constexpr size_t WS_W = 3 * MiB;
constexpr size_t W_IN = 0, W_A = 10 * MiB, W_B = 11 * MiB, W_O = 12 * MiB, W_GU = 14 * MiB, W_D = 25 * MiB;
constexpr size_t WS_U = 34 * MiB;
constexpr size_t WS_YA = 98 * MiB;
constexpr size_t WS_YB = 130 * MiB;
constexpr size_t WS_QKVG = 146 * MiB;
constexpr size_t WS_END = 466 * MiB;

struct Params {
    const float *x, *c, *w_ada, *b_ada, *w_in, *sinks, *w_a, *w_b, *w_o, *ln1_g, *ln1_b, *w_gate, *w_up, *w_down, *ln2_g, *ln2_b;
    float* out; unsigned char* ws;
};

__device__ __forceinline__ int opaque_tid() { int t = threadIdx.x; asm volatile("" : "+v"(t)); return t; }
__device__ __forceinline__ float wave_sum(float v) {
#pragma unroll
    for (int o = 1; o < 64; o <<= 1) v += __shfl_xor(v, o);
    return v;
}

__device__ __forceinline__ void phase_mods(const Params& P, unsigned char* lds) {
    float* red = (float*)lds;
    float* mod = (float*)(P.ws + WS_MOD);
    const int tid = opaque_tid(), kg = tid >> 4, cl = tid & 15;
    for (int item = blockIdx.x; item < DEPTH * 96; item += gridDim.x) {
        const int l = item / 96, j0 = (item % 96) * 64;
        const float* w = P.w_ada + (size_t)l * DM * 6 * DM + j0 + 4 * cl;
        f32x4 a0 = {0.f, 0.f, 0.f, 0.f}, a1 = {0.f, 0.f, 0.f, 0.f};
#pragma unroll 8
        for (int kk = 0; kk < 32; ++kk) { const int k = kg * 32 + kk;
            const f32x4 wv = *(const f32x4*)(w + (size_t)k * 6 * DM);
            const float c0 = P.c[k], c1 = P.c[DM + k];
            const float s0 = c0 / (1.f + __expf(-c0)), s1 = c1 / (1.f + __expf(-c1));
            a0 += wv * s0; a1 += wv * s1; }
        float* rp = red + (kg * 16 + cl) * 8;
        rp[0] = a0[0]; rp[1] = a0[1]; rp[2] = a0[2]; rp[3] = a0[3]; rp[4] = a1[0]; rp[5] = a1[1]; rp[6] = a1[2]; rp[7] = a1[3];
        __syncthreads();
        if (tid < 128) { const int c2 = tid >> 3, i = tid & 7; float s = 0.f;
#pragma unroll 8
            for (int g = 0; g < 32; ++g) s += red[(g * 16 + c2) * 8 + i];
            const int b = i >> 2, col = j0 + 4 * c2 + (i & 3);
            mod[(size_t)(l * 2 + b) * 6 * DM + col] = s + P.b_ada[(size_t)l * 6 * DM + col]; }
        __syncthreads();
    }
}

__device__ __forceinline__ unsigned f2bf(float f) { unsigned u = __builtin_bit_cast(unsigned, f); return (u + 0x7fffu + ((u >> 16) & 1u)) >> 16; }
__device__ __forceinline__ unsigned pk2(float lo, float hi) { return f2bf(lo) | (f2bf(hi) << 16); }
__device__ __forceinline__ void transpose_item(const float* W, int K, int N, bf16* WT, int mode, float* scr, int item, int lane) {
    const int nblk = N / 32, kb = item / nblk, nb = item % nblk, k0 = 64 * kb, n0 = 32 * nb;
    const int drow0 = (mode == 0) ? n0 : ((n0 >> 7) * 256 + (n0 & 127) + (mode == 2 ? 128 : 0));
#pragma unroll 8
    for (int i = 0; i < 32; ++i) { const int kk = 2 * i + (lane >> 5); scr[kk * 33 + (lane & 31)] = W[(size_t)(k0 + kk) * N + n0 + (lane & 31)]; }
    asm volatile("s_waitcnt lgkmcnt(0)" ::: "memory");
    const int c = lane & 7;
#pragma unroll
    for (int j = 0; j < 4; ++j) { const int n = (lane >> 3) + 8 * j; const float* s = scr + (8 * c) * 33 + n;
        v4u o; o.x = pk2(s[0 * 33], s[1 * 33]); o.y = pk2(s[2 * 33], s[3 * 33]); o.z = pk2(s[4 * 33], s[5 * 33]); o.w = pk2(s[6 * 33], s[7 * 33]);
        *(v4u*)(WT + (size_t)(drow0 + n) * K + k0 + 8 * c) = o; }
    asm volatile("s_waitcnt lgkmcnt(0)" ::: "memory");
}
__device__ __forceinline__ void phase_weights(const Params& P, int l, unsigned char* lds) {
    const int tid = opaque_tid(), lane = tid & 63, wave = tid >> 6;
    float* scr = (float*)(lds + wave * 16384);
    bf16* Wb = (bf16*)(P.ws + WS_W);
    constexpr int I_IN = 16 * 160, I_A = 8 * 32, I_B = 4 * 32, I_O = 16 * 32, I_G = 16 * 88, I_D = 44 * 32;
    constexpr int NITEMS = I_IN + I_A + I_B + I_O + 2 * I_G + I_D;
    const int gw = blockIdx.x * NWAVES + wave, NGW = gridDim.x * NWAVES;
    for (int it = gw; it < NITEMS; it += NGW) {
        int r = it;
        if (r < I_IN) { transpose_item(P.w_in + (size_t)l * DM * INW, DM, INW, Wb + W_IN / 2, 0, scr, r, lane); continue; } r -= I_IN;
        if (r < I_A) { transpose_item(P.w_a + (size_t)l * 512 * DM, 512, DM, Wb + W_A / 2, 0, scr, r, lane); continue; } r -= I_A;
        if (r < I_B) { transpose_item(P.w_b + (size_t)l * 256 * DM, 256, DM, Wb + W_B / 2, 0, scr, r, lane); continue; } r -= I_B;
        if (r < I_O) { transpose_item(P.w_o + (size_t)l * DM * DM, DM, DM, Wb + W_O / 2, 0, scr, r, lane); continue; } r -= I_O;
        if (r < I_G) { transpose_item(P.w_gate + (size_t)l * DM * DFF, DM, DFF, Wb + W_GU / 2, 1, scr, r, lane); continue; } r -= I_G;
        if (r < I_G) { transpose_item(P.w_up + (size_t)l * DM * DFF, DM, DFF, Wb + W_GU / 2, 2, scr, r, lane); continue; } r -= I_G;
        transpose_item(P.w_down + (size_t)l * DFF * DM, DFF, DM, Wb + W_D / 2, 0, scr, r, lane);
    }
}

template <bool DO_LN, bool WRITE_X, bool WRITE_U>
__device__ __forceinline__ void phase_rows(const float* src, float* xdst, bf16* udst, const float* gamma, const float* beta, const float* modl, int sc_off, int sh_off) {
    const int tid = opaque_tid(), lane = tid & 63, wave = tid >> 6;
    const int gw = blockIdx.x * NWAVES + wave, NGW = gridDim.x * NWAVES;
    for (int m = gw; m < NTOK; m += NGW) {
        const f32x4* xr = (const f32x4*)(src + (size_t)m * DM) + lane;
        f32x4 v[4];
#pragma unroll
        for (int j = 0; j < 4; ++j) v[j] = xr[64 * j];
        if (DO_LN) {
            float s = 0.f;
#pragma unroll
            for (int j = 0; j < 4; ++j) s += (v[j].x + v[j].y) + (v[j].z + v[j].w);
            const float mean = wave_sum(s) * (1.f / DM); float s2 = 0.f;
#pragma unroll
            for (int j = 0; j < 4; ++j) { v[j] = v[j] - mean; s2 += (v[j].x * v[j].x + v[j].y * v[j].y) + (v[j].z * v[j].z + v[j].w * v[j].w); }
            const float rstd = 1.f / sqrtf(wave_sum(s2) * (1.f / DM) + LN_EPS);
#pragma unroll
            for (int j = 0; j < 4; ++j) { const f32x4 g = ((const f32x4*)gamma)[lane + 64 * j], b = ((const f32x4*)beta)[lane + 64 * j]; v[j] = v[j] * rstd * g + b; }
        }
        if (WRITE_X) { f32x4* xo = (f32x4*)(xdst + (size_t)m * DM) + lane;
#pragma unroll
            for (int j = 0; j < 4; ++j) xo[64 * j] = v[j]; }
        if (WRITE_U) { const float* mb = modl + (m >= SEQ ? 6 * DM : 0); v2u* uo = (v2u*)(udst + (size_t)m * DM) + lane;
#pragma unroll
            for (int j = 0; j < 4; ++j) { const f32x4 sc = ((const f32x4*)(mb + sc_off))[lane + 64 * j], sh = ((const f32x4*)(mb + sh_off))[lane + 64 * j];
                const f32x4 uu = v[j] * (sc + 1.0f) + sh; v2u w; w.x = cvt_pk_bf16(uu.x, uu.y); w.y = cvt_pk_bf16(uu.z, uu.w); uo[64 * j] = w; } }
    }
}

constexpr int KV_STRIDE = 144;
constexpr int KV_ROWS = 384;
constexpr int LDS_K = 0, LDS_V = KV_ROWS * KV_STRIDE;
__device__ __forceinline__ v4i16_t tr_read(const LAS unsigned char* p) { return __builtin_amdgcn_ds_read_tr16_b64_v4i16((LAS v4i16_t*)p); }

__device__ __forceinline__ void phase_attention(const Params& P, int layer, LAS unsigned char* lds) {
    const int tid = opaque_tid(), lane = tid & 63, wave = __builtin_amdgcn_readfirstlane(tid >> 6), r32 = lane & 31, hi = lane >> 5;
    const bf16* QKVG = (const bf16*)(P.ws + WS_QKVG);
    bf16* OG = (bf16*)(P.ws + WS_U);
    bf16* YA = (bf16*)(P.ws + WS_YA);
    float* LSE = (float*)(P.ws + WS_LSE);
    for (int u = blockIdx.x; u < 2560; u += gridDim.x) {
        int b, d, r, n0, nrows, kcol, vcol, qcol, q0, sidx, maxdist, opitch, ocol; bf16* obase; float m_init, l_init; int lse_idx = -1;
        if (u < 1536) {
            const int blk = u & 63, t = u >> 6; b = t / 12; const int g = (t % 12) >> 2, j = t & 3;
            d = 1 << (2 * g); const int nblk = 64 >> (2 * g); r = blk / nblk; n0 = (blk % nblk) * 256; nrows = 384;
            kcol = KB_OFF + g * 256 + j * 64; vcol = VB_OFF + g * 256 + j * 64; qcol = QB_OFF + g * 256 + j * 64; q0 = n0 + 32 * wave;
            sidx = 8 + 4 * g + j; maxdist = 128; obase = OG; opitch = 768; ocol = g * 256 + j * 64; m_init = -1e30f; l_init = 0.f; lse_idx = g * 4 + j;
        } else {
            const int ua = u - 1536, blk = ua & 255, t = ua >> 8; b = t >> 1; const int kvh = t & 1; d = 1; r = 0; n0 = blk * 64; nrows = 192;
            kcol = KA_OFF + kvh * 64; vcol = VA_OFF + kvh * 64; const int head = kvh * 4 + (wave >> 1); qcol = QA_OFF + head * 64; q0 = n0 + 32 * (wave & 1);
            sidx = head; maxdist = 127; obase = YA; opitch = 512; ocol = head * 64; m_init = P.sinks[layer * 8 + head] * LOG2E; l_init = (hi == 0) ? 1.f : 0.f;
        }
        const float slope2 = exp2f(-8.0f * (float)(sidx + 1) / 20.0f) * (float)d * LOG2E;
        bf16x8 qf[4];
        { const size_t qtok = (size_t)b * SEQ + r + (size_t)d * (q0 + r32); const bf16* qp = QKVG + qtok * INW + qcol + 8 * hi;
#pragma unroll
          for (int d0 = 0; d0 < 4; ++d0) qf[d0] = *(const bf16x8*)(qp + 16 * d0); }
        { v4u kr[6], vr[6];
#pragma unroll
          for (int it = 0; it < 6; ++it) { const int c = tid + it * NTHREADS; const int R = c >> 3, ch = c & 7; const int kn = n0 - 128 + R;
              kr[it] = (v4u){0u, 0u, 0u, 0u}; vr[it] = (v4u){0u, 0u, 0u, 0u};
              if (R < nrows && kn >= 0) { const bf16* src = QKVG + ((size_t)b * SEQ + r + (size_t)d * kn) * INW + 8 * ch; kr[it] = *(const v4u*)(src + kcol); vr[it] = *(const v4u*)(src + vcol); } }
#pragma unroll
          for (int it = 0; it < 6; ++it) { const int c = tid + it * NTHREADS; const int R = c >> 3, ch = c & 7;
              if (R < nrows) { *(LAS v4u*)(lds + LDS_K + R * KV_STRIDE + 16 * ch) = kr[it]; *(LAS v4u*)(lds + LDS_V + R * KV_STRIDE + 16 * ch) = vr[it]; } } }
        __syncthreads();
        float m = m_init, l = l_init; f32x16 o0, o1;
#pragma unroll
        for (int i = 0; i < 16; ++i) { o0[i] = 0.f; o1[i] = 0.f; }
        const int rowb = q0 - n0;
        const int kappa = (r32 & ~12) | ((r32 & 4) << 1) | ((r32 & 8) >> 1);
        const LAS unsigned char* kbase = lds + LDS_K + (rowb + kappa) * KV_STRIDE + 16 * hi;
        const LAS unsigned char* vbase = lds + LDS_V + (rowb + 8 * hi + ((lane & 15) >> 2)) * KV_STRIDE + (16 * ((lane >> 4) & 1) + 4 * (lane & 3)) * 2;
#pragma unroll 1
        for (int jt = 0; jt < 5; ++jt) {
            f32x16 S;
#pragma unroll
            for (int i = 0; i < 16; ++i) S[i] = 0.f;
#pragma unroll
            for (int d0 = 0; d0 < 4; ++d0) { const bf16x8 kf = *(const LAS bf16x8*)(kbase + jt * 32 * KV_STRIDE + 32 * d0); S = __builtin_amdgcn_mfma_f32_32x32x16_bf16(kf, qf[d0], S, 0, 0, 0); }
            const int dist0 = r32 + 128 - 32 * jt - 8 * hi, kn0 = q0 - 128 + 32 * jt + 8 * hi;
            float mx = -INFINITY;
#pragma unroll
            for (int i = 0; i < 16; ++i) { const int off = (i & 7) + 16 * (i >> 3); const int dist = dist0 - off, key = kn0 + off;
                const bool valid = (dist >= 0) && (dist <= maxdist) && (key >= 0);
                S[i] = valid ? (S[i] - slope2 * (float)dist) : -INFINITY; mx = fmaxf(mx, S[i]); }
            mx = fmaxf(mx, __shfl_xor(mx, 32));
            const float mn = fmaxf(m, mx), alpha = __builtin_amdgcn_exp2f(m - mn); m = mn;
            float ls = 0.f;
#pragma unroll
            for (int i = 0; i < 16; ++i) { S[i] = __builtin_amdgcn_exp2f(S[i] - mn); ls += S[i]; }
            l = l * alpha + ls;
#pragma unroll
            for (int i = 0; i < 16; ++i) { o0[i] *= alpha; o1[i] *= alpha; }
            bf16x8 pf[2];
#pragma unroll
            for (int s = 0; s < 2; ++s) { v4u w; w.x = cvt_pk_bf16(S[8 * s + 0], S[8 * s + 1]); w.y = cvt_pk_bf16(S[8 * s + 2], S[8 * s + 3]); w.z = cvt_pk_bf16(S[8 * s + 4], S[8 * s + 5]); w.w = cvt_pk_bf16(S[8 * s + 6], S[8 * s + 7]);
                pf[s] = __builtin_bit_cast(bf16x8, w); }
#pragma unroll
            for (int s = 0; s < 2; ++s) {
                const LAS unsigned char* vp = vbase + (jt * 32 + 16 * s) * KV_STRIDE;
                const v4i16_t a0 = tr_read(vp), a1 = tr_read(vp + 4 * KV_STRIDE), b0 = tr_read(vp + 64), b1 = tr_read(vp + 4 * KV_STRIDE + 64);
                const bf16x8 vf0 = (bf16x8){a0[0], a0[1], a0[2], a0[3], a1[0], a1[1], a1[2], a1[3]};
                const bf16x8 vf1 = (bf16x8){b0[0], b0[1], b0[2], b0[3], b1[0], b1[1], b1[2], b1[3]};
                o0 = __builtin_amdgcn_mfma_f32_32x32x16_bf16(vf0, pf[s], o0, 0, 0, 0);
                o1 = __builtin_amdgcn_mfma_f32_32x32x16_bf16(vf1, pf[s], o1, 0, 0, 0);
            }
        }
        l += __shfl_xor(l, 32);
        const float inv = 1.0f / l;
        { const size_t otok = (size_t)b * SEQ + r + (size_t)d * (q0 + r32); bf16* op = obase + otok * opitch + ocol + 4 * hi;
#pragma unroll
          for (int g4 = 0; g4 < 4; ++g4) {
              v2u w0, w1; w0.x = cvt_pk_bf16(o0[4 * g4] * inv, o0[4 * g4 + 1] * inv); w0.y = cvt_pk_bf16(o0[4 * g4 + 2] * inv, o0[4 * g4 + 3] * inv);
              w1.x = cvt_pk_bf16(o1[4 * g4] * inv, o1[4 * g4 + 1] * inv); w1.y = cvt_pk_bf16(o1[4 * g4 + 2] * inv, o1[4 * g4 + 3] * inv);
              *(v2u*)(op + 8 * g4) = w0; *(v2u*)(op + 32 + 8 * g4) = w1; }
          if (lse_idx >= 0 && hi == 0) LSE[otok * 12 + lse_idx] = m + __builtin_amdgcn_logf(l); }
        __syncthreads();
    }
}

__device__ __forceinline__ void phase_combine(const Params& P) {
    const bf16* OG = (const bf16*)(P.ws + WS_U); bf16* YB = (bf16*)(P.ws + WS_YB); const float* LSE = (const float*)(P.ws + WS_LSE);
    const int nth = gridDim.x * NTHREADS;
    for (int idx = blockIdx.x * NTHREADS + opaque_tid(); idx < NTOK * 32; idx += nth) {
        const int tok = idx >> 5, ch = idx & 31, j = ch >> 3;
        const float l0 = LSE[(size_t)tok * 12 + j], l1 = LSE[(size_t)tok * 12 + 4 + j], l2 = LSE[(size_t)tok * 12 + 8 + j];
        const float M = fmaxf(l0, fmaxf(l1, l2));
        float w0 = __builtin_amdgcn_exp2f(l0 - M), w1 = __builtin_amdgcn_exp2f(l1 - M), w2 = __builtin_amdgcn_exp2f(l2 - M);
        const float inv = 1.0f / (w0 + w1 + w2); w0 *= inv; w1 *= inv; w2 *= inv;
        const bf16* op = OG + (size_t)tok * 768 + ch * 8;
        const v4u a = *(const v4u*)op, b = *(const v4u*)(op + 256), c = *(const v4u*)(op + 512);
        v4u o;
        o.x = cvt_pk_bf16(w0 * bf_lo(a.x) + w1 * bf_lo(b.x) + w2 * bf_lo(c.x), w0 * bf_hi(a.x) + w1 * bf_hi(b.x) + w2 * bf_hi(c.x));
        o.y = cvt_pk_bf16(w0 * bf_lo(a.y) + w1 * bf_lo(b.y) + w2 * bf_lo(c.y), w0 * bf_hi(a.y) + w1 * bf_hi(b.y) + w2 * bf_hi(c.y));
        o.z = cvt_pk_bf16(w0 * bf_lo(a.z) + w1 * bf_lo(b.z) + w2 * bf_lo(c.z), w0 * bf_hi(a.z) + w1 * bf_hi(b.z) + w2 * bf_hi(c.z));
        o.w = cvt_pk_bf16(w0 * bf_lo(a.w) + w1 * bf_lo(b.w) + w2 * bf_lo(c.w), w0 * bf_hi(a.w) + w1 * bf_hi(b.w) + w2 * bf_hi(c.w));
        *(v4u*)(YB + (size_t)tok * 256 + ch * 8) = o;
    }
}

template <int l> __device__ __forceinline__ void layer_body(const Params& P, cg::grid_group& grid, unsigned char* lds, LAS unsigned char* L, int G, int bid, float* mod, bf16* Wb, bf16* U, bf16* YA, bf16* YB, bf16* QKVG) {
        const float* modl = mod + (size_t)l * 2 * 6 * DM;
        { pg8::Gemm g{U, Wb + W_IN / 2, NTOK, INW, DM}; pg8::StaticOrder S; S.init(NTOK, INW, G, bid);
          pg8::EpiIn E{QKVG, QSCALE};
          pg8::gemm_phase<pg8::EpiIn, pg8::StaticOrder, true, true>(L, g, S, E); }
        grid.sync();
        phase_attention(P, l, L);
        grid.sync();
        phase_combine(P);
        grid.sync();
        { pg8::Gemm g{YA, Wb + W_A / 2, NTOK, DM, 512}; pg8::StaticOrder S; S.init(NTOK, DM, G, bid);
          pg8::EpiGate<false> E{U, QKVG, GA_OFF};
          pg8::gemm_phase<pg8::EpiGate<false>, pg8::StaticOrder, true, true>(L, g, S, E); }
        { pg8::Gemm g{YB, Wb + W_B / 2, NTOK, DM, 256}; pg8::StaticOrder S; S.init(NTOK, DM, G, bid);
          pg8::EpiGate<true> E{U, QKVG, GB_OFF};
          pg8::gemm_phase<pg8::EpiGate<true>, pg8::StaticOrder, true, true>(L, g, S, E); }
        grid.sync();
        { pg8::Gemm g{U, Wb + W_O / 2, NTOK, DM, DM}; pg8::StaticOrder S; S.init(NTOK, DM, G, bid);
          pg8::EpiRes E{l == 0 ? P.x : P.out, P.out, modl + 2 * DM, modl + 6 * DM + 2 * DM, DN_ALPHA};
          pg8::gemm_phase<pg8::EpiRes, pg8::StaticOrder, true, true>(L, g, S, E); }
        grid.sync();
        phase_rows<true, true, true>(P.out, P.out, U, P.ln1_g + l * DM, P.ln1_b + l * DM, modl, 4 * DM, 3 * DM);
        grid.sync();
        { pg8::Gemm g{U, Wb + W_GU / 2, NTOK, NGU, DM}; pg8::StaticOrder S; S.init(NTOK, NGU, G, bid);
          pg8::EpiSwiGLU E{QKVG};
          pg8::gemm_phase<pg8::EpiSwiGLU, pg8::StaticOrder, true, true>(L, g, S, E); }
        grid.sync();
        { pg8::Gemm g{QKVG, Wb + W_D / 2, NTOK, DM, DFF}; pg8::StaticOrder S; S.init(NTOK, DM, G, bid);
          pg8::EpiRes E{P.out, P.out, modl + 5 * DM, modl + 6 * DM + 5 * DM, DN_ALPHA};
          pg8::gemm_phase<pg8::EpiRes, pg8::StaticOrder, true, true>(L, g, S, E); }
        grid.sync();
        if (l + 1 < DEPTH) {
            phase_rows<true, true, true>(P.out, P.out, U, P.ln2_g + l * DM, P.ln2_b + l * DM, modl + 2 * 6 * DM, 1 * DM, 0 * DM);
            phase_weights(P, l + 1, lds);
            grid.sync();
        } else {
            phase_rows<true, true, false>(P.out, P.out, nullptr, P.ln2_g + l * DM, P.ln2_b + l * DM, nullptr, 0, 0);
        }
}

__global__ void __launch_bounds__(NTHREADS, 2) fwd_megakernel(Params P) {
    extern __shared__ __attribute__((aligned(16))) unsigned char lds[];
    cg::grid_group grid = cg::this_grid();
    LAS unsigned char* L = (LAS unsigned char*)lds;
    const int G = gridDim.x, bid = blockIdx.x;
    unsigned char* ws = P.ws;
    float* mod = (float*)(ws + WS_MOD);
    bf16* Wb = (bf16*)(ws + WS_W);
    bf16* U = (bf16*)(ws + WS_U); bf16* YA = (bf16*)(ws + WS_YA); bf16* YB = (bf16*)(ws + WS_YB); bf16* QKVG = (bf16*)(ws + WS_QKVG);

    phase_mods(P, lds);
    phase_weights(P, 0, lds);
    grid.sync();
    phase_rows<false, false, true>(P.x, nullptr, U, nullptr, nullptr, mod, 1 * DM, 0 * DM);
    grid.sync();

    layer_body<0>(P, grid, lds, L, G, bid, mod, Wb, U, YA, YB, QKVG);
    layer_body<1>(P, grid, lds, L, G, bid, mod, Wb, U, YA, YB, QKVG);
    layer_body<2>(P, grid, lds, L, G, bid, mod, Wb, U, YA, YB, QKVG);
    layer_body<3>(P, grid, lds, L, G, bid, mod, Wb, U, YA, YB, QKVG);
}

extern "C" void kernel_launch(void* const* d_in, const int* in_sizes, int n_in, void* d_out, int out_size, void* d_ws, size_t ws_size, hipStream_t stream) {
    static int grid = 0;
    if (grid == 0) {
        if (n_in != 16 || in_sizes[0] != NTOK * DM || out_size != NTOK * DM || ws_size < WS_END) { fprintf(stderr, "kernel_launch: unexpected shapes (n_in %d, in0 %d, out %d, ws %zu)\n", n_in, n_in > 0 ? in_sizes[0] : -1, out_size, ws_size); grid = -1; return; }
        int dev = 0, cus = 0, per_cu = 0;
        hipGetDevice(&dev); hipDeviceGetAttribute(&cus, hipDeviceAttributeMultiprocessorCount, dev);
        hipFuncSetAttribute((const void*)fwd_megakernel, hipFuncAttributeMaxDynamicSharedMemorySize, LDS_BYTES);
        hipOccupancyMaxActiveBlocksPerMultiprocessor(&per_cu, (const void*)fwd_megakernel, NTHREADS, LDS_BYTES);
        (void)hipGetLastError();
        if (per_cu < 1) { fprintf(stderr, "kernel_launch: occupancy query says %d blocks per CU\n", per_cu); per_cu = 1; }
        grid = cus;
    }
    if (grid < 0) return;
    Params p{};
    p.x = (const float*)d_in[0]; p.c = (const float*)d_in[1]; p.w_ada = (const float*)d_in[2]; p.b_ada = (const float*)d_in[3]; p.w_in = (const float*)d_in[4]; p.sinks = (const float*)d_in[5];
    p.w_a = (const float*)d_in[6]; p.w_b = (const float*)d_in[7]; p.w_o = (const float*)d_in[8]; p.ln1_g = (const float*)d_in[9]; p.ln1_b = (const float*)d_in[10];
    p.w_gate = (const float*)d_in[11]; p.w_up = (const float*)d_in[12]; p.w_down = (const float*)d_in[13]; p.ln2_g = (const float*)d_in[14]; p.ln2_b = (const float*)d_in[15];
    p.out = (float*)d_out; p.ws = (unsigned char*)d_ws;
    void* args[] = {&p};
    hipError_t e = hipLaunchCooperativeKernel((const void*)fwd_megakernel, dim3(grid), dim3(NTHREADS), args, LDS_BYTES, stream);
    if (e != hipSuccess) fprintf(stderr, "kernel_launch: cooperative launch failed: %s (grid %d)\n", hipGetErrorString(e), grid);
}
```

```cpp
#include <hip/hip_runtime.h>
#include <hip/hip_cooperative_groups.h>
#include <cstdio>
#include <cstdint>
namespace cg = cooperative_groups;

constexpr int BATCH = 2, SEQ = 16384, DM = 1024, DEPTH = 4, NTOK = BATCH * SEQ;
constexpr int INW = 5120, DFF = 2816, NGU = 2 * DFF;
constexpr int QA_OFF = 0, KA_OFF = 512, VA_OFF = 640, QB_OFF = 768, KB_OFF = 1536, VB_OFF = 2304, GA_OFF = 3072, GB_OFF = 4096;
constexpr float LN_EPS = 1e-5f;
constexpr float DN_ALPHA = 1.681792830507429f;
constexpr float LOG2E = 1.4426950408889634f;
constexpr float QSCALE = 0.125f * LOG2E;

namespace pg8 {
#define PG8_LAS __attribute__((address_space(3)))
typedef unsigned short bf16_t;
typedef short bf16x8 __attribute__((ext_vector_type(8)));
typedef float f32x4 __attribute__((ext_vector_type(4)));
typedef unsigned u32x4 __attribute__((ext_vector_type(4)));
constexpr int BM = 256, BK = 64, HALF = 128, HTB = HALF * BK * 2  , STAGE_BYTES = 8 * HTB, NXCD = 8, WGM = 8;

__host__ __device__ __forceinline__ int lds_byte(int r, int c) { const int st = (r >> 4) * 2 + (c >> 5), rr = r & 15, cc = c & 31, ob = rr * 64 + cc * 2; return st * 1024 + (ob ^ (((ob >> 9) & 1) << 5)); }
__host__ __device__ __forceinline__ void stage_rc(int b, int& R, int& C) { const int st = b / 1024, sb = b % 1024, swz = sb ^ (((sb >> 9) & 1) << 5); R = (st >> 1) * 16 + swz / 64; C = (st & 1) * 32 + (swz % 64) / 2; }
__host__ __device__ __forceinline__ int perm32(int rho) { const int n = rho >> 4, i = rho & 15; return 8 * (i >> 2) + 4 * n + (i & 3); }

struct Unit { int pm, pn; };
struct Gemm { const bf16_t* A; const bf16_t* Bt; int M, N, K; };

struct StaticOrder {
    int nM, nN, nwg, G, c;
    __host__ __device__ void init(int M, int N, int G_, int c_) { nM = M / BM; nN = N / BM; nwg = nM * nN; G = G_; c = c_; }
    __host__ __device__ bool next(int i, Unit& u) const {
        const long L = (long)i * G + c; if (L >= nwg) return false;
        int wgid = (int)L; { const int q = nwg / NXCD, r = nwg % NXCD, xcd = wgid % NXCD, off = wgid / NXCD; wgid = (xcd < r ? xcd * (q + 1) : r * (q + 1) + (xcd - r) * q) + off; }
        const int nig = WGM * nN, gid = wgid / nig, fm = gid * WGM, gsz = (nM - fm) < WGM ? (nM - fm) : WGM;
        u.pm = fm + ((wgid % nig) % gsz); u.pn = (wgid % nig) / gsz; return true;
    }
    __device__ __forceinline__ void a_ready(const Unit&) const {}
    __device__ __forceinline__ void done(const Unit&) const {}
};

__device__ __forceinline__ unsigned cvt_pk_bf16(float lo, float hi) { unsigned r; asm volatile("v_cvt_pk_bf16_f32 %0, %1, %2" : "=v"(r) : "v"(lo), "v"(hi)); return r; }
__device__ __forceinline__ float bf_lo(unsigned w) { return __uint_as_float(w << 16); }
__device__ __forceinline__ float bf_hi(unsigned w) { return __uint_as_float(w & 0xffff0000u); }
__device__ __forceinline__ float fast_sigmoid(float v) { return __builtin_amdgcn_rcpf(1.0f + __builtin_amdgcn_exp2f(-v * 1.4426950408889634f)); }

struct EpiIn {
    static constexpr bool PERM = true, AFTER_DRAIN = false;
    bf16_t* O; float qscale;
    __device__ __forceinline__ void operator()(const f32x4 (&acc)[2][2][4][2], const Unit& u, int wr, int wc, int fr, int fq) const {
        const int row0 = u.pm * BM + wr * 64 + fr, col0 = u.pn * BM + wc * 32 + 8 * fq;
        const int mode = (u.pn <= 1 || (u.pn >= 3 && u.pn <= 5)) ? 1 : (u.pn >= 12 ? 2 : 0);
#pragma unroll
        for (int ai = 0; ai < 2; ++ai)
#pragma unroll
            for (int m = 0; m < 4; ++m) { bf16_t* rowp = O + (size_t)(row0 + ai * HALF + m * 16) * 5120 + col0;
#pragma unroll
                for (int bj = 0; bj < 2; ++bj) { f32x4 v0 = acc[ai][bj][m][0], v1 = acc[ai][bj][m][1];
                    if (mode == 1) { v0 = v0 * qscale; v1 = v1 * qscale; }
                    else if (mode == 2) {
#pragma unroll
                        for (int e = 0; e < 4; ++e) { v0[e] = fast_sigmoid(v0[e]); v1[e] = fast_sigmoid(v1[e]); } }
                    u32x4 w; w.x = cvt_pk_bf16(v0[0], v0[1]); w.y = cvt_pk_bf16(v0[2], v0[3]); w.z = cvt_pk_bf16(v1[0], v1[1]); w.w = cvt_pk_bf16(v1[2], v1[3]);
                    *(u32x4*)(rowp + bj * HALF) = w; } }
    }
};
template <bool ACCUM> struct EpiGate {
    static constexpr bool PERM = true, AFTER_DRAIN = false;
    bf16_t* O; const bf16_t* G; int goff;
    __device__ __forceinline__ void operator()(const f32x4 (&acc)[2][2][4][2], const Unit& u, int wr, int wc, int fr, int fq) const {
        const int row0 = u.pm * BM + wr * 64 + fr, col0 = u.pn * BM + wc * 32 + 8 * fq;
#pragma unroll
        for (int ai = 0; ai < 2; ++ai)
#pragma unroll
            for (int m = 0; m < 4; ++m) { const size_t row = (size_t)(row0 + ai * HALF + m * 16); bf16_t* rowp = O + row * 1024 + col0; const bf16_t* gp = G + row * 5120 + goff + col0;
#pragma unroll
                for (int bj = 0; bj < 2; ++bj) { const f32x4 v0 = acc[ai][bj][m][0], v1 = acc[ai][bj][m][1];
                    const u32x4 g = *(const u32x4*)(gp + bj * HALF);
                    float o[8];
                    o[0] = bf_lo(g.x) * v0[0]; o[1] = bf_hi(g.x) * v0[1]; o[2] = bf_lo(g.y) * v0[2]; o[3] = bf_hi(g.y) * v0[3];
                    o[4] = bf_lo(g.z) * v1[0]; o[5] = bf_hi(g.z) * v1[1]; o[6] = bf_lo(g.w) * v1[2]; o[7] = bf_hi(g.w) * v1[3];
                    if (ACCUM) { const u32x4 p = *(const u32x4*)(rowp + bj * HALF);
                        o[0] += bf_lo(p.x); o[1] += bf_hi(p.x); o[2] += bf_lo(p.y); o[3] += bf_hi(p.y); o[4] += bf_lo(p.z); o[5] += bf_hi(p.z); o[6] += bf_lo(p.w); o[7] += bf_hi(p.w); }
                    u32x4 w; w.x = cvt_pk_bf16(o[0], o[1]); w.y = cvt_pk_bf16(o[2], o[3]); w.z = cvt_pk_bf16(o[4], o[5]); w.w = cvt_pk_bf16(o[6], o[7]);
                    *(u32x4*)(rowp + bj * HALF) = w; }
                asm volatile("" ::: "memory"); }
    }
};
struct EpiRes {
    static constexpr bool PERM = false, AFTER_DRAIN = false;
    const float* xres; float* z; const float* gmod0; const float* gmod1; float alpha;
    __device__ __forceinline__ void operator()(const f32x4 (&acc)[2][2][4][2], const Unit& u, int wr, int wc, int fr, int fq) const {
        const int row0 = u.pm * BM + wr * 64 + fr, col0 = u.pn * BM + wc * 32 + 4 * fq;
        const float* gm = (u.pm < 64) ? gmod0 : gmod1;
        f32x4 gv[2][2];
#pragma unroll
        for (int bj = 0; bj < 2; ++bj)
#pragma unroll
            for (int n = 0; n < 2; ++n) gv[bj][n] = *(const f32x4*)(gm + col0 + bj * HALF + n * 16);
#pragma unroll
        for (int ai = 0; ai < 2; ++ai)
#pragma unroll
            for (int m = 0; m < 4; ++m) { const size_t off = (size_t)(row0 + ai * HALF + m * 16) * 1024 + col0;
#pragma unroll
                for (int bj = 0; bj < 2; ++bj)
#pragma unroll
                    for (int n = 0; n < 2; ++n) { const f32x4 xv = *(const f32x4*)(xres + off + bj * HALF + n * 16);
                        *(f32x4*)(z + off + bj * HALF + n * 16) = xv * alpha + gv[bj][n] * acc[ai][bj][m][n]; } }
    }
};
struct EpiSwiGLU {
    static constexpr bool PERM = true, AFTER_DRAIN = false;
    bf16_t* O;
    __device__ __forceinline__ void operator()(const f32x4 (&acc)[2][2][4][2], const Unit& u, int wr, int wc, int fr, int fq) const {
        const int row0 = u.pm * BM + wr * 64 + fr, col0 = u.pn * HALF + wc * 32 + 8 * fq;
#pragma unroll
        for (int ai = 0; ai < 2; ++ai)
#pragma unroll
            for (int m = 0; m < 4; ++m) { bf16_t* rowp = O + (size_t)(row0 + ai * HALF + m * 16) * 2816 + col0;
                float o[8];
#pragma unroll
                for (int n = 0; n < 2; ++n)
#pragma unroll
                    for (int e = 0; e < 4; ++e) { const float g = acc[ai][0][m][n][e], up = acc[ai][1][m][n][e]; o[4 * n + e] = g * fast_sigmoid(g) * up; }
                u32x4 w; w.x = cvt_pk_bf16(o[0], o[1]); w.y = cvt_pk_bf16(o[2], o[3]); w.z = cvt_pk_bf16(o[4], o[5]); w.w = cvt_pk_bf16(o[6], o[7]);
                *(u32x4*)(rowp) = w; }
    }
};

template <class Epi, class Sched, bool ALIGN_EPI = false, bool SP2 = false>
__device__ __forceinline__ void gemm_phase(PG8_LAS unsigned char* lds, const Gemm g, const Sched& S, const Epi& E) {
    int tid_ = threadIdx.x; asm volatile("" : "+v"(tid_)); const int tid = tid_, wid = __builtin_amdgcn_readfirstlane(tid >> 6), lane = tid & 63, wr = wid >> 2, wc = wid & 3, fr = lane & 15, fq = lane >> 4;
    const int K = g.K, nt = K / BK;
    unsigned voffA[2], voffB[2];
#pragma unroll
    for (int i = 0; i < 2; ++i) { int R, C; stage_rc(tid * 16 + i * 8192, R, C); const int Rb = Epi::PERM ? ((R & ~31) + perm32(R & 31)) : R;
        voffA[i] = (unsigned)(R * K + C) * 2u; voffB[i] = (unsigned)(Rb * K + C) * 2u; }
    const size_t kstep = (size_t)(BK * 2);
    const size_t hstep = (size_t)HALF * K * 2;
    const size_t tstep = 2 * hstep;
    const unsigned ldsw = (unsigned)wid * 1024u;
    const int aoff = lds_byte(wr * 64 + fr, fq * 8), boff = lds_byte(wc * 32 + fr, fq * 8);
#define PG8_SA(b, h) (((b) * 2 + (h)) * HTB)
#define PG8_SB(b, h) ((4 + (b) * 2 + (h)) * HTB)
#define PG8_STAGE(bufoff, gbase, voff) do { _Pragma("unroll") for (int _i = 0; _i < 2; ++_i) \
        __builtin_amdgcn_global_load_lds((const unsigned*)((const char*)(gbase) + (voff)[_i]), (PG8_LAS unsigned*)(lds + (bufoff) + ldsw + _i * 8192), 16, 0, 0); } while (0)
#define PG8_LDA(dst, b, h) do { _Pragma("unroll") for (int m = 0; m < 4; ++m) _Pragma("unroll") for (int k = 0; k < 2; ++k) dst[m][k] = *(const PG8_LAS bf16x8*)(lds + PG8_SA(b, h) + aoff + m * 2048 + k * 1024); } while (0)
#define PG8_LDB(dst, b, h) do { _Pragma("unroll") for (int n = 0; n < 2; ++n) _Pragma("unroll") for (int k = 0; k < 2; ++k) dst[n][k] = *(const PG8_LAS bf16x8*)(lds + PG8_SB(b, h) + boff + n * 2048 + k * 1024); } while (0)
#define PG8_MMA(ai, bj, At, Bt) do { __builtin_amdgcn_s_setprio(1); _Pragma("unroll") for (int m = 0; m < 4; ++m) _Pragma("unroll") for (int n = 0; n < 2; ++n) _Pragma("unroll") for (int k = 0; k < 2; ++k) \
        acc[ai][bj][m][n] = __builtin_amdgcn_mfma_f32_16x16x32_bf16(Bt[n][k], At[m][k], acc[ai][bj][m][n], 0, 0, 0); __builtin_amdgcn_s_setprio(0); } while (0)
#define PG8_WAIT_V(n) asm volatile("s_waitcnt vmcnt(" #n ")" ::: "memory")
#define PG8_WAIT_L(n) asm volatile("s_waitcnt lgkmcnt(" #n ")" ::: "memory")
#define PG8_BAR __builtin_amdgcn_s_barrier()
#define PG8_SCHED __builtin_amdgcn_sched_barrier(0)
    Unit cur, nxt; int ui = 0;
    if (!S.next(0, cur)) return;
    f32x4 acc[2][2][4][2];
#pragma unroll
    for (int a = 0; a < 2; ++a)
#pragma unroll
        for (int b = 0; b < 2; ++b)
#pragma unroll
            for (int m = 0; m < 4; ++m)
#pragma unroll
                for (int n = 0; n < 2; ++n) acc[a][b][m][n] = (f32x4){0.f, 0.f, 0.f, 0.f};
    bf16x8 At[4][2], B0[2][2], B1[2][2];
    const char* cA = (const char*)g.A + (size_t)cur.pm * tstep; const char* cB = (const char*)g.Bt + (size_t)cur.pn * tstep;
    S.a_ready(cur);
    if constexpr (SP2) {
        PG8_STAGE(PG8_SB(0, 0), cB, voffB); PG8_STAGE(PG8_SB(0, 1), cB + hstep, voffB); PG8_STAGE(PG8_SA(0, 0), cA, voffA); PG8_STAGE(PG8_SA(0, 1), cA + hstep, voffA);
        if (wr == 1) PG8_BAR;
        PG8_WAIT_V(2); PG8_BAR;
        PG8_STAGE(PG8_SB(1, 0), cB + kstep, voffB); PG8_STAGE(PG8_SA(1, 0), cA + kstep, voffA); PG8_STAGE(PG8_SB(1, 1), cB + hstep + kstep, voffB);
        PG8_WAIT_V(6); PG8_BAR;
    } else {
        PG8_STAGE(PG8_SB(0, 0), cB, voffB); PG8_STAGE(PG8_SA(0, 0), cA, voffA); PG8_STAGE(PG8_SB(0, 1), cB + hstep, voffB); PG8_STAGE(PG8_SA(0, 1), cA + hstep, voffA);
        if (wr == 1) PG8_BAR;
        PG8_WAIT_V(4); PG8_BAR;
        PG8_STAGE(PG8_SB(1, 0), cB + kstep, voffB); PG8_STAGE(PG8_SA(1, 0), cA + kstep, voffA); PG8_STAGE(PG8_SB(1, 1), cB + hstep + kstep, voffB);
        PG8_WAIT_V(6); PG8_BAR;
    }
    for (;;) {
        const bool has_next = S.next(ui + 1, nxt);
        const char* nA = has_next ? (const char*)g.A + (size_t)nxt.pm * tstep : cA; const char* nB = has_next ? (const char*)g.Bt + (size_t)nxt.pn * tstep : cB;
        for (int t = 0; t < nt; t += 2) {
            const bool last = (t == nt - 2);
            const char* a1 = cA + (size_t)(t + 1) * kstep;
            const char* a2 = last ? nA : cA + (size_t)(t + 2) * kstep; const char* b2 = last ? nB : cB + (size_t)(t + 2) * kstep;
            const char* a3 = a2 + kstep; const char* b3 = b2 + kstep;
            if (last && has_next) S.a_ready(nxt);
            if constexpr (SP2) {
            PG8_LDB(B0, 0, 0); PG8_LDB(B1, 0, 1); PG8_SCHED; PG8_LDA(At, 0, 0); PG8_STAGE(PG8_SA(1, 1), a1 + hstep, voffA);
            PG8_WAIT_V(8); PG8_WAIT_L(0); PG8_BAR; PG8_MMA(0, 0, At, B0); PG8_MMA(0, 1, At, B1); PG8_BAR; PG8_SCHED;
            PG8_LDA(At, 0, 1); PG8_STAGE(PG8_SB(0, 0), b2, voffB); PG8_STAGE(PG8_SB(0, 1), b2 + hstep, voffB); PG8_STAGE(PG8_SA(0, 0), a2, voffA);
            PG8_WAIT_V(8); PG8_WAIT_L(0); PG8_BAR; PG8_MMA(1, 0, At, B0); PG8_MMA(1, 1, At, B1); PG8_BAR; PG8_SCHED;
            PG8_LDB(B0, 1, 0); PG8_LDB(B1, 1, 1); PG8_SCHED; PG8_LDA(At, 1, 0); PG8_STAGE(PG8_SA(0, 1), a2 + hstep, voffA);
            PG8_WAIT_V(8); PG8_WAIT_L(0); PG8_BAR; PG8_MMA(0, 0, At, B0); PG8_MMA(0, 1, At, B1); PG8_BAR; PG8_SCHED;
            PG8_LDA(At, 1, 1); PG8_STAGE(PG8_SB(1, 0), b3, voffB); PG8_STAGE(PG8_SB(1, 1), b3 + hstep, voffB); PG8_STAGE(PG8_SA(1, 0), a3, voffA);
            PG8_WAIT_V(8); PG8_WAIT_L(0); PG8_BAR; PG8_MMA(1, 0, At, B0); PG8_MMA(1, 1, At, B1); PG8_BAR; PG8_SCHED;
            } else {
            PG8_LDB(B0, 0, 0); PG8_SCHED; PG8_LDA(At, 0, 0); PG8_STAGE(PG8_SA(1, 1), a1 + hstep, voffA);
            PG8_WAIT_L(8); PG8_BAR; PG8_WAIT_L(0); PG8_MMA(0, 0, At, B0); PG8_BAR; PG8_SCHED;
            PG8_LDB(B1, 0, 1); PG8_STAGE(PG8_SB(0, 0), b2, voffB);
            PG8_BAR; PG8_WAIT_L(0); PG8_MMA(0, 1, At, B1); PG8_BAR;
            PG8_LDA(At, 0, 1); PG8_STAGE(PG8_SA(0, 0), a2, voffA);
            PG8_BAR; PG8_WAIT_L(0); PG8_MMA(1, 0, At, B0); PG8_BAR; PG8_SCHED;
            PG8_STAGE(PG8_SB(0, 1), b2 + hstep, voffB);
            PG8_WAIT_V(6); PG8_BAR; PG8_MMA(1, 1, At, B1); PG8_BAR;
            PG8_LDB(B0, 1, 0); PG8_SCHED; PG8_LDA(At, 1, 0); PG8_STAGE(PG8_SA(0, 1), a2 + hstep, voffA);
            PG8_WAIT_L(8); PG8_BAR; PG8_WAIT_L(0); PG8_MMA(0, 0, At, B0); PG8_BAR; PG8_SCHED;
            PG8_LDB(B1, 1, 1); PG8_STAGE(PG8_SB(1, 0), b3, voffB);
            PG8_BAR; PG8_WAIT_L(0); PG8_MMA(0, 1, At, B1); PG8_BAR;
            PG8_LDA(At, 1, 1); PG8_STAGE(PG8_SA(1, 0), a3, voffA);
            PG8_BAR; PG8_WAIT_L(0); PG8_MMA(1, 0, At, B0); PG8_BAR; PG8_SCHED;
            PG8_STAGE(PG8_SB(1, 1), b3 + hstep, voffB);
            PG8_WAIT_V(6); PG8_BAR; PG8_MMA(1, 1, At, B1); PG8_BAR;
            }
        }
        if constexpr (ALIGN_EPI) { if (wr == 0) PG8_BAR; }
        if constexpr (!Epi::AFTER_DRAIN) { E(acc, cur, wr, wc, fr, fq); S.done(cur); }
        if (!has_next) break;
#pragma unroll
        for (int a = 0; a < 2; ++a)
#pragma unroll
            for (int b = 0; b < 2; ++b)
#pragma unroll
                for (int m = 0; m < 4; ++m)
#pragma unroll
                    for (int n = 0; n < 2; ++n) acc[a][b][m][n] = (f32x4){0.f, 0.f, 0.f, 0.f};
        cur = nxt; cA = nA; cB = nB; ++ui;
        if constexpr (ALIGN_EPI) { if (wr == 1) PG8_BAR; }
    }
    PG8_WAIT_V(0);
    if constexpr (!ALIGN_EPI) { if (wr == 0) PG8_BAR; }
    PG8_BAR;
    if constexpr (Epi::AFTER_DRAIN) { E.fused(acc, cur, wr, wc, fr, fq, lds, wid, lane); S.done(cur); }
#undef PG8_SA
#undef PG8_SB
#undef PG8_STAGE
#undef PG8_LDA
#undef PG8_LDB
#undef PG8_MMA
#undef PG8_WAIT_V
#undef PG8_WAIT_L
#undef PG8_BAR
#undef PG8_SCHED
}
}

#define LAS __attribute__((address_space(3)))
typedef unsigned short bf16;
typedef unsigned v4u __attribute__((ext_vector_type(4)));
typedef unsigned v2u __attribute__((ext_vector_type(2)));
typedef float f32x4 __attribute__((ext_vector_type(4)));
typedef float f32x16 __attribute__((ext_vector_type(16)));
typedef short bf16x8 __attribute__((ext_vector_type(8)));
typedef short v4i16_t __attribute__((ext_vector_type(4)));
using pg8::cvt_pk_bf16; using pg8::bf_lo; using pg8::bf_hi;

#define XB_TMO      128
#define XB_XCNT(j)  (256  + 64 * (j))
#define XB_XSUB(j)  (1280 + 64 * (j))
#define XB_XGEN(j)  (2304 + 64 * (j))
#define XB_TOP      3328
#define XB_TOPGEN   3392
#define XCD_BAR_WORDS 3456
#define XB_SPIN_CAP (1u << 18)

__device__ __forceinline__ unsigned xb_ld(unsigned* p)              { return __hip_atomic_load(p, __ATOMIC_RELAXED, __HIP_MEMORY_SCOPE_AGENT); }
__device__ __forceinline__ unsigned xb_add(unsigned* p, unsigned v) { return __hip_atomic_fetch_add(p, v, __ATOMIC_RELAXED, __HIP_MEMORY_SCOPE_AGENT); }
__device__ __forceinline__ unsigned xb_xcc_id() { return (unsigned)__builtin_amdgcn_s_getreg((3 << 11) | 20) & 0xFu; }
#define XB_SPIN(cond, bar) do { unsigned _sp = 0; while (cond) { __builtin_amdgcn_s_sleep(1); \
    if ((++_sp & 255u) == 0u) { if (xb_ld(&(bar)[XB_TMO])) break; if (_sp > XB_SPIN_CAP) { atomicAdd(&(bar)[XB_TMO], 1u); break; } } } } while (0)

struct XcdBarrier {
    unsigned* bar; unsigned x;
    volatile LAS unsigned* st;
};

__device__ __forceinline__ XcdBarrier xcd_barrier_post(unsigned* bar, volatile LAS unsigned* st) {
    XcdBarrier b; b.bar = bar; b.x = xb_xcc_id(); b.st = st;
    if (threadIdx.x == 0) (void)xb_add(&bar[XB_XCNT(b.x)], 1u);
    return b;
}
__device__ __forceinline__ void xcd_barrier_complete(unsigned* bar, unsigned x, unsigned& nloc, unsigned& nx) {
    const unsigned G = gridDim.x * gridDim.y * gridDim.z;
    unsigned sum, cnt, mine, sp = 0u;
    for (;;) {
        sum = 0u; cnt = 0u; mine = 0u;
#pragma unroll
        for (unsigned j = 0; j < 16; ++j) { const unsigned c = xb_ld(&bar[XB_XCNT(j)]); sum += c; cnt += (c > 0u) ? 1u : 0u; mine = (j == x) ? c : mine; }
        if (sum == G) break;
        __builtin_amdgcn_s_sleep(1);
        if ((++sp & 255u) == 0u) { if (xb_ld(&bar[XB_TMO])) break; if (sp > XB_SPIN_CAP) { atomicAdd(&bar[XB_TMO], 1u); break; } }
    }
    nloc = mine > 0u ? mine : 1u; nx = cnt > 0u ? cnt : 1u;
}

__device__ __forceinline__ void xcd_barrier(const XcdBarrier& b) {
    asm volatile("s_waitcnt vmcnt(0)" ::: "memory");
    __syncthreads();
    if (threadIdx.x == 0) {
        unsigned* bar = b.bar;
        __builtin_amdgcn_s_waitcnt(0);
        unsigned nloc = b.st[0], nx = b.st[1];
        if (nloc == 0u) { xcd_barrier_complete(bar, b.x, nloc, nx); b.st[0] = nloc; b.st[1] = nx; }
        const unsigned old = xb_add(&bar[XB_XSUB(b.x)], 1u);
        const unsigned gen = old / nloc;
        if (old + 1u == (gen + 1u) * nloc) {
            __builtin_amdgcn_fence(__ATOMIC_RELEASE, "agent");
            asm volatile("s_waitcnt vmcnt(0)" ::: "memory");
            const unsigned og = xb_add(&bar[XB_TOP], 1u);
            const unsigned tg = og / nx;
            if (og + 1u == (tg + 1u) * nx) xb_add(&bar[XB_TOPGEN], 1u);
            else XB_SPIN(xb_ld(&bar[XB_TOPGEN]) == tg, bar);
            __builtin_amdgcn_fence(__ATOMIC_ACQUIRE, "agent");
            xb_add(&bar[XB_XGEN(b.x)], 1u);
            asm volatile("s_waitcnt vmcnt(0)" ::: "memory");
        } else {
            XB_SPIN(xb_ld(&bar[XB_XGEN(b.x)]) == gen, bar);
            __builtin_amdgcn_fence(__ATOMIC_ACQUIRE, "agent");
            asm volatile("s_waitcnt vmcnt(0)" ::: "memory");
        }
    }
    __syncthreads();
}


constexpr int NWAVES = 8, NTHREADS = 512;
constexpr int LDS_BYTES = 147456;
constexpr int MISC_OFF = 131072 + 320;
constexpr size_t MiB = 1u << 20;
constexpr size_t WS_MOD = 0;
constexpr size_t WS_BAR = 512 * 1024;
constexpr size_t WS_LSE = 1 * MiB;
constexpr size_t WS_W = 3 * MiB;
constexpr size_t W_IN = 0, W_A = 10 * MiB, W_B = 11 * MiB, W_O = 12 * MiB, W_GU = 14 * MiB, W_D = 25 * MiB;
constexpr size_t WS_U = 34 * MiB;
constexpr size_t WS_YA = 98 * MiB;
constexpr size_t WS_YB = 130 * MiB;
constexpr size_t WS_QKVG = 146 * MiB;
constexpr size_t WS_END = 466 * MiB;

struct Params {
    const float *x, *c, *w_ada, *b_ada, *w_in, *sinks, *w_a, *w_b, *w_o, *ln1_g, *ln1_b, *w_gate, *w_up, *w_down, *ln2_g, *ln2_b;
    float* out; unsigned char* ws;
};

__device__ __forceinline__ int opaque_tid() { int t = threadIdx.x; asm volatile("" : "+v"(t)); return t; }
__device__ __forceinline__ float wave_sum(float v) {
#pragma unroll
    for (int o = 1; o < 64; o <<= 1) v += __shfl_xor(v, o);
    return v;
}

__device__ __forceinline__ void phase_mods(const Params& P, unsigned char* lds) {
    float* red = (float*)lds;
    float* mod = (float*)(P.ws + WS_MOD);
    const int tid = opaque_tid(), kg = tid >> 4, cl = tid & 15;
    for (int item = blockIdx.x; item < DEPTH * 96; item += gridDim.x) {
        const int l = item / 96, j0 = (item % 96) * 64;
        const float* w = P.w_ada + (size_t)l * DM * 6 * DM + j0 + 4 * cl;
        f32x4 a0 = {0.f, 0.f, 0.f, 0.f}, a1 = {0.f, 0.f, 0.f, 0.f};
#pragma unroll 8
        for (int kk = 0; kk < 32; ++kk) { const int k = kg * 32 + kk;
            const f32x4 wv = *(const f32x4*)(w + (size_t)k * 6 * DM);
            const float c0 = P.c[k], c1 = P.c[DM + k];
            const float s0 = c0 / (1.f + __expf(-c0)), s1 = c1 / (1.f + __expf(-c1));
            a0 += wv * s0; a1 += wv * s1; }
        float* rp = red + (kg * 16 + cl) * 8;
        rp[0] = a0[0]; rp[1] = a0[1]; rp[2] = a0[2]; rp[3] = a0[3]; rp[4] = a1[0]; rp[5] = a1[1]; rp[6] = a1[2]; rp[7] = a1[3];
        __syncthreads();
        if (tid < 128) { const int c2 = tid >> 3, i = tid & 7; float s = 0.f;
#pragma unroll 8
            for (int g = 0; g < 32; ++g) s += red[(g * 16 + c2) * 8 + i];
            const int b = i >> 2, col = j0 + 4 * c2 + (i & 3);
            mod[(size_t)(l * 2 + b) * 6 * DM + col] = s + P.b_ada[(size_t)l * 6 * DM + col]; }
        __syncthreads();
    }
}

__device__ __forceinline__ unsigned f2bf(float f) { unsigned u = __builtin_bit_cast(unsigned, f); return (u + 0x7fffu + ((u >> 16) & 1u)) >> 16; }
__device__ __forceinline__ unsigned pk2(float lo, float hi) { return f2bf(lo) | (f2bf(hi) << 16); }
__device__ __forceinline__ void transpose_item(const float* W, int K, int N, bf16* WT, int mode, float* scr, int item, int lane) {
    const int nblk = N / 32, kb = item / nblk, nb = item % nblk, k0 = 64 * kb, n0 = 32 * nb;
    const int drow0 = (mode == 0) ? n0 : ((n0 >> 7) * 256 + (n0 & 127) + (mode == 2 ? 128 : 0));
#pragma unroll 8
    for (int i = 0; i < 32; ++i) { const int kk = 2 * i + (lane >> 5); scr[kk * 33 + (lane & 31)] = W[(size_t)(k0 + kk) * N + n0 + (lane & 31)]; }
    asm volatile("s_waitcnt lgkmcnt(0)" ::: "memory");
    const int c = lane & 7;
#pragma unroll
    for (int j = 0; j < 4; ++j) { const int n = (lane >> 3) + 8 * j; const float* s = scr + (8 * c) * 33 + n;
        v4u o; o.x = pk2(s[0 * 33], s[1 * 33]); o.y = pk2(s[2 * 33], s[3 * 33]); o.z = pk2(s[4 * 33], s[5 * 33]); o.w = pk2(s[6 * 33], s[7 * 33]);
        *(v4u*)(WT + (size_t)(drow0 + n) * K + k0 + 8 * c) = o; }
    asm volatile("s_waitcnt lgkmcnt(0)" ::: "memory");
}
__device__ __forceinline__ void phase_weights(const Params& P, int l, unsigned char* lds) {
    const int tid = opaque_tid(), lane = tid & 63, wave = tid >> 6;
    float* scr = (float*)(lds + wave * 16384);
    bf16* Wb = (bf16*)(P.ws + WS_W);
    constexpr int I_IN = 16 * 160, I_A = 8 * 32, I_B = 4 * 32, I_O = 16 * 32, I_G = 16 * 88, I_D = 44 * 32;
    constexpr int NITEMS = I_IN + I_A + I_B + I_O + 2 * I_G + I_D;
    const int gw = blockIdx.x * NWAVES + wave, NGW = gridDim.x * NWAVES;
    for (int it = gw; it < NITEMS; it += NGW) {
        int r = it;
        if (r < I_IN) { transpose_item(P.w_in + (size_t)l * DM * INW, DM, INW, Wb + W_IN / 2, 0, scr, r, lane); continue; } r -= I_IN;
        if (r < I_A) { transpose_item(P.w_a + (size_t)l * 512 * DM, 512, DM, Wb + W_A / 2, 0, scr, r, lane); continue; } r -= I_A;
        if (r < I_B) { transpose_item(P.w_b + (size_t)l * 256 * DM, 256, DM, Wb + W_B / 2, 0, scr, r, lane); continue; } r -= I_B;
        if (r < I_O) { transpose_item(P.w_o + (size_t)l * DM * DM, DM, DM, Wb + W_O / 2, 0, scr, r, lane); continue; } r -= I_O;
        if (r < I_G) { transpose_item(P.w_gate + (size_t)l * DM * DFF, DM, DFF, Wb + W_GU / 2, 1, scr, r, lane); continue; } r -= I_G;
        if (r < I_G) { transpose_item(P.w_up + (size_t)l * DM * DFF, DM, DFF, Wb + W_GU / 2, 2, scr, r, lane); continue; } r -= I_G;
        transpose_item(P.w_down + (size_t)l * DFF * DM, DFF, DM, Wb + W_D / 2, 0, scr, r, lane);
    }
}

template <bool DO_LN, bool WRITE_X, bool WRITE_U>
__device__ __forceinline__ void phase_rows(const float* src, float* xdst, bf16* udst, const float* gamma, const float* beta, const float* modl, int sc_off, int sh_off) {
    const int tid = opaque_tid(), lane = tid & 63, wave = tid >> 6;
    const int gw = blockIdx.x * NWAVES + wave, NGW = gridDim.x * NWAVES;
    for (int m = gw; m < NTOK; m += NGW) {
        const f32x4* xr = (const f32x4*)(src + (size_t)m * DM) + lane;
        f32x4 v[4];
#pragma unroll
        for (int j = 0; j < 4; ++j) v[j] = xr[64 * j];
        if (DO_LN) {
            float s = 0.f;
#pragma unroll
            for (int j = 0; j < 4; ++j) s += (v[j].x + v[j].y) + (v[j].z + v[j].w);
            const float mean = wave_sum(s) * (1.f / DM); float s2 = 0.f;
#pragma unroll
            for (int j = 0; j < 4; ++j) { v[j] = v[j] - mean; s2 += (v[j].x * v[j].x + v[j].y * v[j].y) + (v[j].z * v[j].z + v[j].w * v[j].w); }
            const float rstd = 1.f / sqrtf(wave_sum(s2) * (1.f / DM) + LN_EPS);
#pragma unroll
            for (int j = 0; j < 4; ++j) { const f32x4 g = ((const f32x4*)gamma)[lane + 64 * j], b = ((const f32x4*)beta)[lane + 64 * j]; v[j] = v[j] * rstd * g + b; }
        }
        if (WRITE_X) { f32x4* xo = (f32x4*)(xdst + (size_t)m * DM) + lane;
#pragma unroll
            for (int j = 0; j < 4; ++j) xo[64 * j] = v[j]; }
        if (WRITE_U) { const float* mb = modl + (m >= SEQ ? 6 * DM : 0); v2u* uo = (v2u*)(udst + (size_t)m * DM) + lane;
#pragma unroll
            for (int j = 0; j < 4; ++j) { const f32x4 sc = ((const f32x4*)(mb + sc_off))[lane + 64 * j], sh = ((const f32x4*)(mb + sh_off))[lane + 64 * j];
                const f32x4 uu = v[j] * (sc + 1.0f) + sh; v2u w; w.x = cvt_pk_bf16(uu.x, uu.y); w.y = cvt_pk_bf16(uu.z, uu.w); uo[64 * j] = w; } }
    }
}

constexpr int KV_STRIDE = 144;
constexpr int KV_ROWS = 384;
constexpr int LDS_K = 0, LDS_V = KV_ROWS * KV_STRIDE;
__device__ __forceinline__ v4i16_t tr_read(const LAS unsigned char* p) { return __builtin_amdgcn_ds_read_tr16_b64_v4i16((LAS v4i16_t*)p); }

__device__ __forceinline__ void phase_attention(const Params& P, int layer, LAS unsigned char* lds) {
    const int tid = opaque_tid(), lane = tid & 63, wave = __builtin_amdgcn_readfirstlane(tid >> 6), r32 = lane & 31, hi = lane >> 5;
    const bf16* QKVG = (const bf16*)(P.ws + WS_QKVG);
    bf16* OG = (bf16*)(P.ws + WS_U);
    bf16* YA = (bf16*)(P.ws + WS_YA);
    float* LSE = (float*)(P.ws + WS_LSE);
    for (int u = blockIdx.x; u < 2560; u += gridDim.x) {
        int b, d, r, n0, nrows, kcol, vcol, qcol, q0, sidx, maxdist, opitch, ocol; bf16* obase; float m_init, l_init; int lse_idx = -1;
        if (u < 1536) {
            const int blk = u & 63, t = u >> 6; b = t / 12; const int g = (t % 12) >> 2, j = t & 3;
            d = 1 << (2 * g); const int nblk = 64 >> (2 * g); r = blk / nblk; n0 = (blk % nblk) * 256; nrows = 384;
            kcol = KB_OFF + g * 256 + j * 64; vcol = VB_OFF + g * 256 + j * 64; qcol = QB_OFF + g * 256 + j * 64; q0 = n0 + 32 * wave;
            sidx = 8 + 4 * g + j; maxdist = 128; obase = OG; opitch = 768; ocol = g * 256 + j * 64; m_init = -1e30f; l_init = 0.f; lse_idx = g * 4 + j;
        } else {
            const int ua = u - 1536, blk = ua & 255, t = ua >> 8; b = t >> 1; const int kvh = t & 1; d = 1; r = 0; n0 = blk * 64; nrows = 192;
            kcol = KA_OFF + kvh * 64; vcol = VA_OFF + kvh * 64; const int head = kvh * 4 + (wave >> 1); qcol = QA_OFF + head * 64; q0 = n0 + 32 * (wave & 1);
            sidx = head; maxdist = 127; obase = YA; opitch = 512; ocol = head * 64; m_init = P.sinks[layer * 8 + head] * LOG2E; l_init = (hi == 0) ? 1.f : 0.f;
        }
        const float slope2 = exp2f(-8.0f * (float)(sidx + 1) / 20.0f) * (float)d * LOG2E;
        bf16x8 qf[4];
        { const size_t qtok = (size_t)b * SEQ + r + (size_t)d * (q0 + r32); const bf16* qp = QKVG + qtok * INW + qcol + 8 * hi;
#pragma unroll
          for (int d0 = 0; d0 < 4; ++d0) qf[d0] = *(const bf16x8*)(qp + 16 * d0); }
        { v4u kr[6], vr[6];
#pragma unroll
          for (int it = 0; it < 6; ++it) { const int c = tid + it * NTHREADS; const int R = c >> 3, ch = c & 7; const int kn = n0 - 128 + R;
              kr[it] = (v4u){0u, 0u, 0u, 0u}; vr[it] = (v4u){0u, 0u, 0u, 0u};
              if (R < nrows && kn >= 0) { const bf16* src = QKVG + ((size_t)b * SEQ + r + (size_t)d * kn) * INW + 8 * ch; kr[it] = *(const v4u*)(src + kcol); vr[it] = *(const v4u*)(src + vcol); } }
#pragma unroll
          for (int it = 0; it < 6; ++it) { const int c = tid + it * NTHREADS; const int R = c >> 3, ch = c & 7;
              if (R < nrows) { *(LAS v4u*)(lds + LDS_K + R * KV_STRIDE + 16 * ch) = kr[it]; *(LAS v4u*)(lds + LDS_V + R * KV_STRIDE + 16 * ch) = vr[it]; } } }
        __syncthreads();
        float m = m_init, l = l_init; f32x16 o0, o1;
#pragma unroll
        for (int i = 0; i < 16; ++i) { o0[i] = 0.f; o1[i] = 0.f; }
        const int rowb = q0 - n0;
        const int kappa = (r32 & ~12) | ((r32 & 4) << 1) | ((r32 & 8) >> 1);
        const LAS unsigned char* kbase = lds + LDS_K + (rowb + kappa) * KV_STRIDE + 16 * hi;
        const LAS unsigned char* vbase = lds + LDS_V + (rowb + 8 * hi + ((lane & 15) >> 2)) * KV_STRIDE + (16 * ((lane >> 4) & 1) + 4 * (lane & 3)) * 2;
#pragma unroll 1
        for (int jt = 0; jt < 5; ++jt) {
            f32x16 S;
#pragma unroll
            for (int i = 0; i < 16; ++i) S[i] = 0.f;
#pragma unroll
            for (int d0 = 0; d0 < 4; ++d0) { const bf16x8 kf = *(const LAS bf16x8*)(kbase + jt * 32 * KV_STRIDE + 32 * d0); S = __builtin_amdgcn_mfma_f32_32x32x16_bf16(kf, qf[d0], S, 0, 0, 0); }
            const int dist0 = r32 + 128 - 32 * jt - 8 * hi, kn0 = q0 - 128 + 32 * jt + 8 * hi;
            float mx = -INFINITY;
#pragma unroll
            for (int i = 0; i < 16; ++i) { const int off = (i & 7) + 16 * (i >> 3); const int dist = dist0 - off, key = kn0 + off;
                const bool valid = (dist >= 0) && (dist <= maxdist) && (key >= 0);
                S[i] = valid ? (S[i] - slope2 * (float)dist) : -INFINITY; mx = fmaxf(mx, S[i]); }
            mx = fmaxf(mx, __shfl_xor(mx, 32));
            const float mn = fmaxf(m, mx), alpha = __builtin_amdgcn_exp2f(m - mn); m = mn;
            float ls = 0.f;
#pragma unroll
            for (int i = 0; i < 16; ++i) { S[i] = __builtin_amdgcn_exp2f(S[i] - mn); ls += S[i]; }
            l = l * alpha + ls;
#pragma unroll
            for (int i = 0; i < 16; ++i) { o0[i] *= alpha; o1[i] *= alpha; }
            bf16x8 pf[2];
#pragma unroll
            for (int s = 0; s < 2; ++s) { v4u w; w.x = cvt_pk_bf16(S[8 * s + 0], S[8 * s + 1]); w.y = cvt_pk_bf16(S[8 * s + 2], S[8 * s + 3]); w.z = cvt_pk_bf16(S[8 * s + 4], S[8 * s + 5]); w.w = cvt_pk_bf16(S[8 * s + 6], S[8 * s + 7]);
                pf[s] = __builtin_bit_cast(bf16x8, w); }
#pragma unroll
            for (int s = 0; s < 2; ++s) {
                const LAS unsigned char* vp = vbase + (jt * 32 + 16 * s) * KV_STRIDE;
                const v4i16_t a0 = tr_read(vp), a1 = tr_read(vp + 4 * KV_STRIDE), b0 = tr_read(vp + 64), b1 = tr_read(vp + 4 * KV_STRIDE + 64);
                const bf16x8 vf0 = (bf16x8){a0[0], a0[1], a0[2], a0[3], a1[0], a1[1], a1[2], a1[3]};
                const bf16x8 vf1 = (bf16x8){b0[0], b0[1], b0[2], b0[3], b1[0], b1[1], b1[2], b1[3]};
                o0 = __builtin_amdgcn_mfma_f32_32x32x16_bf16(vf0, pf[s], o0, 0, 0, 0);
                o1 = __builtin_amdgcn_mfma_f32_32x32x16_bf16(vf1, pf[s], o1, 0, 0, 0);
            }
        }
        l += __shfl_xor(l, 32);
        const float inv = 1.0f / l;
        { const size_t otok = (size_t)b * SEQ + r + (size_t)d * (q0 + r32); bf16* op = obase + otok * opitch + ocol + 4 * hi;
#pragma unroll
          for (int g4 = 0; g4 < 4; ++g4) {
              v2u w0, w1; w0.x = cvt_pk_bf16(o0[4 * g4] * inv, o0[4 * g4 + 1] * inv); w0.y = cvt_pk_bf16(o0[4 * g4 + 2] * inv, o0[4 * g4 + 3] * inv);
              w1.x = cvt_pk_bf16(o1[4 * g4] * inv, o1[4 * g4 + 1] * inv); w1.y = cvt_pk_bf16(o1[4 * g4 + 2] * inv, o1[4 * g4 + 3] * inv);
              *(v2u*)(op + 8 * g4) = w0; *(v2u*)(op + 32 + 8 * g4) = w1; }
          if (lse_idx >= 0 && hi == 0) LSE[otok * 12 + lse_idx] = m + __builtin_amdgcn_logf(l); }
        __syncthreads();
    }
}

__device__ __forceinline__ void phase_combine(const Params& P) {
    const bf16* OG = (const bf16*)(P.ws + WS_U); bf16* YB = (bf16*)(P.ws + WS_YB); const float* LSE = (const float*)(P.ws + WS_LSE);
    const int nth = gridDim.x * NTHREADS;
    for (int idx = blockIdx.x * NTHREADS + opaque_tid(); idx < NTOK * 32; idx += nth) {
        const int tok = idx >> 5, ch = idx & 31, j = ch >> 3;
        const float l0 = LSE[(size_t)tok * 12 + j], l1 = LSE[(size_t)tok * 12 + 4 + j], l2 = LSE[(size_t)tok * 12 + 8 + j];
        const float M = fmaxf(l0, fmaxf(l1, l2));
        float w0 = __builtin_amdgcn_exp2f(l0 - M), w1 = __builtin_amdgcn_exp2f(l1 - M), w2 = __builtin_amdgcn_exp2f(l2 - M);
        const float inv = 1.0f / (w0 + w1 + w2); w0 *= inv; w1 *= inv; w2 *= inv;
        const bf16* op = OG + (size_t)tok * 768 + ch * 8;
        const v4u a = *(const v4u*)op, b = *(const v4u*)(op + 256), c = *(const v4u*)(op + 512);
        v4u o;
        o.x = cvt_pk_bf16(w0 * bf_lo(a.x) + w1 * bf_lo(b.x) + w2 * bf_lo(c.x), w0 * bf_hi(a.x) + w1 * bf_hi(b.x) + w2 * bf_hi(c.x));
        o.y = cvt_pk_bf16(w0 * bf_lo(a.y) + w1 * bf_lo(b.y) + w2 * bf_lo(c.y), w0 * bf_hi(a.y) + w1 * bf_hi(b.y) + w2 * bf_hi(c.y));
        o.z = cvt_pk_bf16(w0 * bf_lo(a.z) + w1 * bf_lo(b.z) + w2 * bf_lo(c.z), w0 * bf_hi(a.z) + w1 * bf_hi(b.z) + w2 * bf_hi(c.z));
        o.w = cvt_pk_bf16(w0 * bf_lo(a.w) + w1 * bf_lo(b.w) + w2 * bf_lo(c.w), w0 * bf_hi(a.w) + w1 * bf_hi(b.w) + w2 * bf_hi(c.w));
        *(v4u*)(YB + (size_t)tok * 256 + ch * 8) = o;
    }
}

template <int l> __device__ __forceinline__ void layer_body(const Params& P, const XcdBarrier& bar, unsigned char* lds, LAS unsigned char* L, int G, int bid, float* mod, bf16* Wb, bf16* U, bf16* YA, bf16* YB, bf16* QKVG) {
        const float* modl = mod + (size_t)l * 2 * 6 * DM;
        { pg8::Gemm g{U, Wb + W_IN / 2, NTOK, INW, DM}; pg8::StaticOrder S; S.init(NTOK, INW, G, bid);
          pg8::EpiIn E{QKVG, QSCALE};
          pg8::gemm_phase<pg8::EpiIn, pg8::StaticOrder, true, true>(L, g, S, E); }
        xcd_barrier(bar);
        phase_attention(P, l, L);
        xcd_barrier(bar);
        phase_combine(P);
        xcd_barrier(bar);
        { pg8::Gemm g{YA, Wb + W_A / 2, NTOK, DM, 512}; pg8::StaticOrder S; S.init(NTOK, DM, G, bid);
          pg8::EpiGate<false> E{U, QKVG, GA_OFF};
          pg8::gemm_phase<pg8::EpiGate<false>, pg8::StaticOrder, true, true>(L, g, S, E); }
        { pg8::Gemm g{YB, Wb + W_B / 2, NTOK, DM, 256}; pg8::StaticOrder S; S.init(NTOK, DM, G, bid);
          pg8::EpiGate<true> E{U, QKVG, GB_OFF};
          pg8::gemm_phase<pg8::EpiGate<true>, pg8::StaticOrder, true, true>(L, g, S, E); }
        xcd_barrier(bar);
        { pg8::Gemm g{U, Wb + W_O / 2, NTOK, DM, DM}; pg8::StaticOrder S; S.init(NTOK, DM, G, bid);
          pg8::EpiRes E{l == 0 ? P.x : P.out, P.out, modl + 2 * DM, modl + 6 * DM + 2 * DM, DN_ALPHA};
          pg8::gemm_phase<pg8::EpiRes, pg8::StaticOrder, true, true>(L, g, S, E); }
        xcd_barrier(bar);
        phase_rows<true, true, true>(P.out, P.out, U, P.ln1_g + l * DM, P.ln1_b + l * DM, modl, 4 * DM, 3 * DM);
        xcd_barrier(bar);
        { pg8::Gemm g{U, Wb + W_GU / 2, NTOK, NGU, DM}; pg8::StaticOrder S; S.init(NTOK, NGU, G, bid);
          pg8::EpiSwiGLU E{QKVG};
          pg8::gemm_phase<pg8::EpiSwiGLU, pg8::StaticOrder, true, true>(L, g, S, E); }
        xcd_barrier(bar);
        { pg8::Gemm g{QKVG, Wb + W_D / 2, NTOK, DM, DFF}; pg8::StaticOrder S; S.init(NTOK, DM, G, bid);
          pg8::EpiRes E{P.out, P.out, modl + 5 * DM, modl + 6 * DM + 5 * DM, DN_ALPHA};
          pg8::gemm_phase<pg8::EpiRes, pg8::StaticOrder, true, true>(L, g, S, E); }
        xcd_barrier(bar);
        if (l + 1 < DEPTH) {
            phase_rows<true, true, true>(P.out, P.out, U, P.ln2_g + l * DM, P.ln2_b + l * DM, modl + 2 * 6 * DM, 1 * DM, 0 * DM);
            phase_weights(P, l + 1, lds);
            xcd_barrier(bar);
        } else {
            phase_rows<true, true, false>(P.out, P.out, nullptr, P.ln2_g + l * DM, P.ln2_b + l * DM, nullptr, 0, 0);
        }
}

__global__ void __launch_bounds__(NTHREADS, 2) fwd_megakernel(Params P) {
    extern __shared__ __attribute__((aligned(16))) unsigned char lds[];
    cg::grid_group grid = cg::this_grid();
    LAS unsigned char* L = (LAS unsigned char*)lds;
    const int G = gridDim.x, bid = blockIdx.x;
    unsigned char* ws = P.ws;
    float* mod = (float*)(ws + WS_MOD);
    bf16* Wb = (bf16*)(ws + WS_W);
    bf16* U = (bf16*)(ws + WS_U); bf16* YA = (bf16*)(ws + WS_YA); bf16* YB = (bf16*)(ws + WS_YB); bf16* QKVG = (bf16*)(ws + WS_QKVG);

    unsigned* barw = (unsigned*)(ws + WS_BAR);
    if (bid == 0) for (int i = threadIdx.x; i < XCD_BAR_WORDS; i += NTHREADS) __hip_atomic_store(barw + i, 0u, __ATOMIC_RELAXED, __HIP_MEMORY_SCOPE_AGENT);
    volatile LAS unsigned* MISC = (volatile LAS unsigned*)(L + MISC_OFF);
    if (threadIdx.x < 32) MISC[threadIdx.x] = 0u;
    __syncthreads();
    phase_mods(P, lds);
    phase_weights(P, 0, lds);
    grid.sync();
    const XcdBarrier bar = xcd_barrier_post(barw, MISC + 8);
    phase_rows<false, false, true>(P.x, nullptr, U, nullptr, nullptr, mod, 1 * DM, 0 * DM);
    xcd_barrier(bar);

    layer_body<0>(P, bar, lds, L, G, bid, mod, Wb, U, YA, YB, QKVG);
    layer_body<1>(P, bar, lds, L, G, bid, mod, Wb, U, YA, YB, QKVG);
    layer_body<2>(P, bar, lds, L, G, bid, mod, Wb, U, YA, YB, QKVG);
    layer_body<3>(P, bar, lds, L, G, bid, mod, Wb, U, YA, YB, QKVG);
}

extern "C" void kernel_launch(void* const* d_in, const int* in_sizes, int n_in, void* d_out, int out_size, void* d_ws, size_t ws_size, hipStream_t stream) {
    static int grid = 0;
    if (grid == 0) {
        if (n_in != 16 || in_sizes[0] != NTOK * DM || out_size != NTOK * DM || ws_size < WS_END) { fprintf(stderr, "kernel_launch: unexpected shapes (n_in %d, in0 %d, out %d, ws %zu)\n", n_in, n_in > 0 ? in_sizes[0] : -1, out_size, ws_size); grid = -1; return; }
        int dev = 0, cus = 0, per_cu = 0;
        hipGetDevice(&dev); hipDeviceGetAttribute(&cus, hipDeviceAttributeMultiprocessorCount, dev);
        hipFuncSetAttribute((const void*)fwd_megakernel, hipFuncAttributeMaxDynamicSharedMemorySize, LDS_BYTES);
        hipOccupancyMaxActiveBlocksPerMultiprocessor(&per_cu, (const void*)fwd_megakernel, NTHREADS, LDS_BYTES);
        (void)hipGetLastError();
        if (per_cu < 1) { fprintf(stderr, "kernel_launch: occupancy query says %d blocks per CU\n", per_cu); per_cu = 1; }
        grid = cus;
    }
    if (grid < 0) return;
    Params p{};
    p.x = (const float*)d_in[0]; p.c = (const float*)d_in[1]; p.w_ada = (const float*)d_in[2]; p.b_ada = (const float*)d_in[3]; p.w_in = (const float*)d_in[4]; p.sinks = (const float*)d_in[5];
    p.w_a = (const float*)d_in[6]; p.w_b = (const float*)d_in[7]; p.w_o = (const float*)d_in[8]; p.ln1_g = (const float*)d_in[9]; p.ln1_b = (const float*)d_in[10];
    p.w_gate = (const float*)d_in[11]; p.w_up = (const float*)d_in[12]; p.w_down = (const float*)d_in[13]; p.ln2_g = (const float*)d_in[14]; p.ln2_b = (const float*)d_in[15];
    p.out = (float*)d_out; p.ws = (unsigned char*)d_ws;
    void* args[] = {&p};
    hipError_t e = hipLaunchCooperativeKernel((const void*)fwd_megakernel, dim3(grid), dim3(NTHREADS), args, LDS_BYTES, stream);
    if (e != hipSuccess) fprintf(stderr, "kernel_launch: cooperative launch failed: %s (grid %d)\n", hipGetErrorString(e), grid);
}
```

```cpp
#include <hip/hip_runtime.h>
#include <hip/hip_cooperative_groups.h>
#include <cstdio>
#include <cstdint>
namespace cg = cooperative_groups;

constexpr int BATCH = 2, SEQ = 16384, DM = 1024, DEPTH = 4, NTOK = BATCH * SEQ;
constexpr int INW = 5120, DFF = 2816, NGU = 2 * DFF;
constexpr int QA_OFF = 0, KA_OFF = 512, VA_OFF = 640, QB_OFF = 768, KB_OFF = 1536, VB_OFF = 2304, GA_OFF = 3072, GB_OFF = 4096;
constexpr float LN_EPS = 1e-5f;
constexpr float DN_ALPHA = 1.681792830507429f;
constexpr float LOG2E = 1.4426950408889634f;
constexpr float QSCALE = 0.125f * LOG2E;

namespace pg8 {
#define PG8_LAS __attribute__((address_space(3)))
typedef unsigned short bf16_t;
typedef short bf16x8 __attribute__((ext_vector_type(8)));
typedef float f32x4 __attribute__((ext_vector_type(4)));
typedef _Float16 f16x8 __attribute__((ext_vector_type(8)));
typedef _Float16 f16x2 __attribute__((ext_vector_type(2)));
template <bool F16> __device__ __forceinline__ f32x4 mma16(bf16x8 a, bf16x8 b, f32x4 c) {
    if constexpr (F16) return __builtin_amdgcn_mfma_f32_16x16x32_f16(__builtin_bit_cast(f16x8, a), __builtin_bit_cast(f16x8, b), c, 0, 0, 0);
    else return __builtin_amdgcn_mfma_f32_16x16x32_bf16(a, b, c, 0, 0, 0);
}
__device__ __forceinline__ unsigned pk_f16(float lo, float hi) { const f16x2 v = {(_Float16)lo, (_Float16)hi}; return __builtin_bit_cast(unsigned, v); }
__device__ __forceinline__ float h_lo(unsigned w) { return (float)__builtin_bit_cast(f16x2, w).x; }
__device__ __forceinline__ float h_hi(unsigned w) { return (float)__builtin_bit_cast(f16x2, w).y; }
typedef unsigned u32x4 __attribute__((ext_vector_type(4)));
constexpr int BM = 256, BK = 64, HALF = 128, HTB = HALF * BK * 2  , STAGE_BYTES = 8 * HTB, NXCD = 8, WGM = 8;

__host__ __device__ __forceinline__ int lds_byte(int r, int c) { const int st = (r >> 4) * 2 + (c >> 5), rr = r & 15, cc = c & 31, ob = rr * 64 + cc * 2; return st * 1024 + (ob ^ (((ob >> 9) & 1) << 5)); }
__host__ __device__ __forceinline__ void stage_rc(int b, int& R, int& C) { const int st = b / 1024, sb = b % 1024, swz = sb ^ (((sb >> 9) & 1) << 5); R = (st >> 1) * 16 + swz / 64; C = (st & 1) * 32 + (swz % 64) / 2; }
__host__ __device__ __forceinline__ int perm32(int rho) { const int n = rho >> 4, i = rho & 15; return 8 * (i >> 2) + 4 * n + (i & 3); }

struct Unit { int pm, pn; };
struct Gemm { const bf16_t* A; const bf16_t* Bt; int M, N, K; const bf16_t* Bt1; int mb; };

struct StaticOrder {
    int nM, nN, nwg, G, c;
    __host__ __device__ void init(int M, int N, int G_, int c_) { nM = M / BM; nN = N / BM; nwg = nM * nN; G = G_; c = c_; }
    __host__ __device__ bool next(int i, Unit& u) const {
        const long L = (long)i * G + c; if (L >= nwg) return false;
        int wgid = (int)L; { const int q = nwg / NXCD, r = nwg % NXCD, xcd = wgid % NXCD, off = wgid / NXCD; wgid = (xcd < r ? xcd * (q + 1) : r * (q + 1) + (xcd - r) * q) + off; }
        const int nig = WGM * nN, gid = wgid / nig, fm = gid * WGM, gsz = (nM - fm) < WGM ? (nM - fm) : WGM;
        u.pm = fm + ((wgid % nig) % gsz); u.pn = (wgid % nig) / gsz; return true;
    }
    __device__ __forceinline__ void a_ready(const Unit&) const {}
    __device__ __forceinline__ void done(const Unit&) const {}
};

__device__ __forceinline__ unsigned cvt_pk_bf16(float lo, float hi) { unsigned r; asm volatile("v_cvt_pk_bf16_f32 %0, %1, %2" : "=v"(r) : "v"(lo), "v"(hi)); return r; }
__device__ __forceinline__ float bf_lo(unsigned w) { return __uint_as_float(w << 16); }
__device__ __forceinline__ float bf_hi(unsigned w) { return __uint_as_float(w & 0xffff0000u); }
__device__ __forceinline__ float fast_sigmoid(float v) { return __builtin_amdgcn_rcpf(1.0f + __builtin_amdgcn_exp2f(-v * 1.4426950408889634f)); }
typedef unsigned u32x2 __attribute__((ext_vector_type(2)));
typedef float f32x2 __attribute__((ext_vector_type(2)));

__device__ __forceinline__ void row_stats(const float* stat, size_t row, int fq, float& rstd, float& nmr) {
    const f32x4* p = (const f32x4*)(stat + row * 32 + 8 * fq);
    const f32x4 a = p[0], b = p[1];
    float s = (a[0] + a[2]) + (b[0] + b[2]), q = (a[1] + a[3]) + (b[1] + b[3]);
    s += __shfl_xor(s, 16); q += __shfl_xor(q, 16); s += __shfl_xor(s, 32); q += __shfl_xor(q, 32);
    const float mean = s * (1.0f / 1024.0f), var = q * (1.0f / 1024.0f) - mean * mean;
    rstd = __builtin_amdgcn_rsqf(var + 1e-5f); nmr = -rstd * mean;
}

constexpr int EPI_TAB = 131072 + 1024, EPI_VEC = EPI_TAB + 8192;
struct PanelSlots { int pm0, pm1, pm2, pm3; __device__ __forceinline__ int slot(int pm) const { return pm == pm0 ? 0 : (pm == pm1 ? 1 : (pm == pm2 ? 2 : 3)); } };
__device__ __forceinline__ PG8_LAS unsigned char* epi_lds(int off) { return (PG8_LAS unsigned char*)(unsigned)off; }
__device__ __forceinline__ void dma_vec(const float* src, PG8_LAS unsigned char* dst) { __builtin_amdgcn_global_load_lds((const unsigned*)src, (PG8_LAS unsigned*)dst, 4, 0, 0); }
template <bool LN> struct EpiIn {
    static constexpr bool PERM = true, AFTER_DRAIN = false;
    bf16_t* QKV; bf16_t* GATES; float qscale; int pm0, pm1, pm2, pm3; const float* cs; const float* bi;
    __device__ __forceinline__ void prefetch(const Unit& u, int wid, int wc, int lane) const {
        const int vo = (u.pm >= 64 ? 5120 : 0) + u.pn * BM + wc * 32 + (lane >> 5) * HALF + (lane & 31);
        dma_vec(cs + vo, epi_lds(EPI_VEC) + wid * 512); dma_vec(bi + vo, epi_lds(EPI_VEC) + wid * 512 + 256);
    }
    __device__ __forceinline__ void init(f32x4 (&acc)[2][2][4][2], const Unit&, int, int, int, int) const {
#pragma unroll
        for (int a = 0; a < 2; ++a)
#pragma unroll
            for (int b = 0; b < 2; ++b)
#pragma unroll
                for (int m = 0; m < 4; ++m)
#pragma unroll
                    for (int n = 0; n < 2; ++n) acc[a][b][m][n] = (f32x4){0.f, 0.f, 0.f, 0.f};
    }
    __device__ __forceinline__ void operator()(const f32x4 (&acc)[2][2][4][2], const Unit& u, int wr, int wc, int fr_, int fq_) const {
        int fr = fr_, fq = fq_; asm volatile("" : "+v"(fr), "+v"(fq));
        const int row0 = u.pm * BM + wr * 64 + fr, cl0 = wc * 32 + 8 * fq;
        const int mode = (u.pn <= 1 || (u.pn >= 3 && u.pn <= 5)) ? 1 : (u.pn >= 12 ? 2 : 0);
        bf16_t* obase; int pitch;
        if (u.pn < 12) { obase = QKV + u.pn * BM + cl0; pitch = 3072; } else { obase = GATES + (u.pn - 12) * BM + cl0; pitch = 2048; }
        f32x4 csv[2][2], biv[2][2]; float rsa[2][4], nma[2][4];
        { const PG8_LAS unsigned char* vb = epi_lds(EPI_VEC) + (wr * 4 + wc) * 512 + 32 * fq;
#pragma unroll
          for (int bj = 0; bj < 2; ++bj)
#pragma unroll
              for (int n = 0; n < 2; ++n) { csv[bj][n] = *(const PG8_LAS f32x4*)(vb + bj * 128 + 16 * n); biv[bj][n] = *(const PG8_LAS f32x4*)(vb + 256 + bj * 128 + 16 * n); }
          const PG8_LAS unsigned char* tb = epi_lds(EPI_TAB) + ((u.pm == pm0 ? 0 : (u.pm == pm1 ? 1 : (u.pm == pm2 ? 2 : 3))) * 256 + wr * 64 + fr) * 8;
#pragma unroll
          for (int ai = 0; ai < 2; ++ai)
#pragma unroll
              for (int m = 0; m < 4; ++m) { rsa[ai][m] = 1.f; nma[ai][m] = 0.f; if (LN) { const f32x2 t = *(const PG8_LAS f32x2*)(tb + (ai * HALF + m * 16) * 8); rsa[ai][m] = t.x; nma[ai][m] = t.y; } } }
#pragma unroll
        for (int ai = 0; ai < 2; ++ai)
#pragma unroll
            for (int m = 0; m < 4; ++m) { const size_t row = (size_t)(row0 + ai * HALF + m * 16); bf16_t* rowp = obase + row * pitch;
                const float rstd = rsa[ai][m], nmr = nma[ai][m];
#pragma unroll
                for (int bj = 0; bj < 2; ++bj) { f32x4 v0 = acc[ai][bj][m][0] * rstd + (csv[bj][0] * nmr + biv[bj][0]), v1 = acc[ai][bj][m][1] * rstd + (csv[bj][1] * nmr + biv[bj][1]);
                    if (mode == 1) { v0 = v0 * qscale; v1 = v1 * qscale; }
                    else if (mode == 2) {
#pragma unroll
                        for (int e = 0; e < 4; ++e) { v0[e] = fast_sigmoid(v0[e]); v1[e] = fast_sigmoid(v1[e]); } }
                    u32x4 w; w.x = cvt_pk_bf16(v0[0], v0[1]); w.y = cvt_pk_bf16(v0[2], v0[3]); w.z = cvt_pk_bf16(v1[0], v1[1]); w.w = cvt_pk_bf16(v1[2], v1[3]);
                    *(u32x4*)(rowp + bj * HALF) = w; } }
    }
};
template <bool ACCUM> struct EpiGate {
    static constexpr bool PERM = true, AFTER_DRAIN = false;
    bf16_t* O; const bf16_t* G; int goff;
    __device__ __forceinline__ void prefetch(const Unit&, int, int, int) const {}
    __device__ __forceinline__ void init(f32x4 (&acc)[2][2][4][2], const Unit&, int, int, int, int) const {
#pragma unroll
        for (int a = 0; a < 2; ++a)
#pragma unroll
            for (int b = 0; b < 2; ++b)
#pragma unroll
                for (int m = 0; m < 4; ++m)
#pragma unroll
                    for (int n = 0; n < 2; ++n) acc[a][b][m][n] = (f32x4){0.f, 0.f, 0.f, 0.f};
    }
    __device__ __forceinline__ void operator()(const f32x4 (&acc)[2][2][4][2], const Unit& u, int wr, int wc, int fr_, int fq_) const {
        int fr = fr_, fq = fq_; asm volatile("" : "+v"(fr), "+v"(fq));
        const int row0 = u.pm * BM + wr * 64 + fr, col0 = u.pn * BM + wc * 32 + 8 * fq;
#pragma unroll
        for (int ai = 0; ai < 2; ++ai) {
            u32x4 gq[4][2], pq[4][2];
#pragma unroll
            for (int m = 0; m < 4; ++m)
#pragma unroll
                for (int bj = 0; bj < 2; ++bj) { const size_t row = (size_t)(row0 + ai * HALF + m * 16);
                    gq[m][bj] = *(const u32x4*)(G + row * 2048 + goff + col0 + bj * HALF);
                    if (ACCUM) pq[m][bj] = *(const u32x4*)(O + row * 1024 + col0 + bj * HALF); }
#pragma unroll
            for (int m = 0; m < 4; ++m) { const size_t row = (size_t)(row0 + ai * HALF + m * 16); bf16_t* rowp = O + row * 1024 + col0;
#pragma unroll
                for (int bj = 0; bj < 2; ++bj) { const f32x4 v0 = acc[ai][bj][m][0], v1 = acc[ai][bj][m][1];
                    const u32x4 g = gq[m][bj];
                    float o[8];
                    o[0] = bf_lo(g.x) * v0[0]; o[1] = bf_hi(g.x) * v0[1]; o[2] = bf_lo(g.y) * v0[2]; o[3] = bf_hi(g.y) * v0[3];
                    o[4] = bf_lo(g.z) * v1[0]; o[5] = bf_hi(g.z) * v1[1]; o[6] = bf_lo(g.w) * v1[2]; o[7] = bf_hi(g.w) * v1[3];
                    if (ACCUM) { const u32x4 p = pq[m][bj];
                        o[0] += bf_lo(p.x); o[1] += bf_hi(p.x); o[2] += bf_lo(p.y); o[3] += bf_hi(p.y); o[4] += bf_lo(p.z); o[5] += bf_hi(p.z); o[6] += bf_lo(p.w); o[7] += bf_hi(p.w); }
                    u32x4 w; w.x = cvt_pk_bf16(o[0], o[1]); w.y = cvt_pk_bf16(o[2], o[3]); w.z = cvt_pk_bf16(o[4], o[5]); w.w = cvt_pk_bf16(o[6], o[7]);
                    *(u32x4*)(rowp + bj * HALF) = w; } }
            asm volatile("" ::: "memory"); }
    }
};
template <bool LN> struct EpiRes {
    static constexpr bool PERM = true, AFTER_DRAIN = false;
    const float* xin; bf16_t* zh; const float* stat_in; float* stat_out; const float* gamma; const float* beta; float alpha;
    __device__ __forceinline__ void prefetch(const Unit&, int, int, int) const {}
    __device__ __forceinline__ void init(f32x4 (&acc)[2][2][4][2], const Unit& u, int wr, int wc, int fr_, int fq_) const {
        int fr = fr_, fq = fq_; asm volatile("" : "+v"(fr), "+v"(fq));
        const int row0 = u.pm * BM + wr * 64 + fr, col0 = u.pn * BM + wc * 32 + 8 * fq;
        float rs[2][4], nm[2][4];
#pragma unroll
        for (int ai = 0; ai < 2; ++ai) {
#pragma unroll
            for (int m = 0; m < 4; ++m) { rs[ai][m] = alpha; nm[ai][m] = 0.f; if (LN) row_stats(stat_in, (size_t)(row0 + ai * HALF + m * 16), fq, rs[ai][m], nm[ai][m]); }
            asm volatile("" ::: "memory"); }
#pragma unroll
        for (int bj = 0; bj < 2; ++bj) { const int c = col0 + bj * HALF;
            f32x4 ga0 = {1.f, 1.f, 1.f, 1.f}, ga1 = ga0, be0 = {0.f, 0.f, 0.f, 0.f}, be1 = be0;
            if (LN) { ga0 = *(const f32x4*)(gamma + c) * alpha; ga1 = *(const f32x4*)(gamma + c + 4) * alpha; be0 = *(const f32x4*)(beta + c) * alpha; be1 = *(const f32x4*)(beta + c + 4) * alpha; }
#pragma unroll
            for (int ai = 0; ai < 2; ++ai)
#pragma unroll
                for (int m = 0; m < 4; ++m) { const size_t off = (size_t)(row0 + ai * HALF + m * 16) * 1024 + c;
                    if (LN) { const u32x4 h = *(const u32x4*)(zh + off);
                        const f32x4 z0 = {h_lo(h.x), h_hi(h.x), h_lo(h.y), h_hi(h.y)}, z1 = {h_lo(h.z), h_hi(h.z), h_lo(h.w), h_hi(h.w)};
                        acc[ai][bj][m][0] = (z0 * rs[ai][m] + nm[ai][m]) * ga0 + be0; acc[ai][bj][m][1] = (z1 * rs[ai][m] + nm[ai][m]) * ga1 + be1; }
                    else { acc[ai][bj][m][0] = __builtin_nontemporal_load((const f32x4*)(xin + off)) * rs[ai][m]; acc[ai][bj][m][1] = __builtin_nontemporal_load((const f32x4*)(xin + off + 4)) * rs[ai][m]; } } }
    }
    __device__ __forceinline__ void operator()(const f32x4 (&acc)[2][2][4][2], const Unit& u, int wr, int wc, int fr_, int fq_) const {
        int fr = fr_, fq = fq_; asm volatile("" : "+v"(fr), "+v"(fq));
        const int row0 = u.pm * BM + wr * 64 + fr, col0 = u.pn * BM + wc * 32 + 8 * fq;
#pragma unroll
        for (int ai = 0; ai < 2; ++ai)
#pragma unroll
            for (int m = 0; m < 4; ++m) { const size_t rowo = (size_t)(row0 + ai * HALF + m * 16); float s = 0.f, q = 0.f;
#pragma unroll
                for (int bj = 0; bj < 2; ++bj) { const size_t off = rowo * 1024 + col0 + bj * HALF; const f32x4 z0 = acc[ai][bj][m][0], z1 = acc[ai][bj][m][1];
                    u32x4 w; w.x = pk_f16(z0[0], z0[1]); w.y = pk_f16(z0[2], z0[3]); w.z = pk_f16(z1[0], z1[1]); w.w = pk_f16(z1[2], z1[3]); *(u32x4*)(zh + off) = w;
                    s += ((z0[0] + z0[1]) + (z0[2] + z0[3])) + ((z1[0] + z1[1]) + (z1[2] + z1[3]));
                    q += ((z0[0] * z0[0] + z0[1] * z0[1]) + (z0[2] * z0[2] + z0[3] * z0[3])) + ((z1[0] * z1[0] + z1[1] * z1[1]) + (z1[2] * z1[2] + z1[3] * z1[3])); }
                s += __shfl_xor(s, 16); q += __shfl_xor(q, 16); s += __shfl_xor(s, 32); q += __shfl_xor(q, 32);
                if (fq == 0) { f32x2 o = {s, q}; *(f32x2*)(stat_out + (rowo * 16 + u.pn * 4 + wc) * 2) = o; } }
    }
};
struct EpiSwiGLU {
    static constexpr bool PERM = true, AFTER_DRAIN = false;
    bf16_t* O; int pm0, pm1, pm2, pm3; const float* cs; const float* bi;
    __device__ __forceinline__ void prefetch(const Unit& u, int wid, int wc, int lane) const {
        const int vo = (u.pm >= 64 ? 5632 : 0) + u.pn * BM + wc * 32 + (lane >> 5) * HALF + (lane & 31);
        dma_vec(cs + vo, epi_lds(EPI_VEC) + wid * 512); dma_vec(bi + vo, epi_lds(EPI_VEC) + wid * 512 + 256);
    }
    __device__ __forceinline__ void init(f32x4 (&acc)[2][2][4][2], const Unit&, int, int, int, int) const {
#pragma unroll
        for (int a = 0; a < 2; ++a)
#pragma unroll
            for (int b = 0; b < 2; ++b)
#pragma unroll
                for (int m = 0; m < 4; ++m)
#pragma unroll
                    for (int n = 0; n < 2; ++n) acc[a][b][m][n] = (f32x4){0.f, 0.f, 0.f, 0.f};
    }
    __device__ __forceinline__ void operator()(const f32x4 (&acc)[2][2][4][2], const Unit& u, int wr, int wc, int fr_, int fq_) const {
        int fr = fr_, fq = fq_; asm volatile("" : "+v"(fr), "+v"(fq));
        const int row0 = u.pm * BM + wr * 64 + fr, col0 = u.pn * HALF + wc * 32 + 8 * fq;
        f32x4 csv[2][2], biv[2][2]; float rsa[2][4], nma[2][4];
        { const PG8_LAS unsigned char* vb = epi_lds(EPI_VEC) + (wr * 4 + wc) * 512 + 32 * fq;
#pragma unroll
          for (int bj = 0; bj < 2; ++bj)
#pragma unroll
              for (int n = 0; n < 2; ++n) { csv[bj][n] = *(const PG8_LAS f32x4*)(vb + bj * 128 + 16 * n); biv[bj][n] = *(const PG8_LAS f32x4*)(vb + 256 + bj * 128 + 16 * n); }
          const PG8_LAS unsigned char* tb = epi_lds(EPI_TAB) + ((u.pm == pm0 ? 0 : (u.pm == pm1 ? 1 : (u.pm == pm2 ? 2 : 3))) * 256 + wr * 64 + fr) * 8;
#pragma unroll
          for (int ai = 0; ai < 2; ++ai)
#pragma unroll
              for (int m = 0; m < 4; ++m) { const f32x2 t = *(const PG8_LAS f32x2*)(tb + (ai * HALF + m * 16) * 8); rsa[ai][m] = t.x; nma[ai][m] = t.y; } }
#pragma unroll
        for (int ai = 0; ai < 2; ++ai) {
#pragma unroll
            for (int m = 0; m < 4; ++m) { const size_t row = (size_t)(row0 + ai * HALF + m * 16); bf16_t* rowp = O + row * 2816 + col0;
                const float rstd = rsa[ai][m], nmr = nma[ai][m];
                float o[8];
#pragma unroll
                for (int n = 0; n < 2; ++n) { const f32x4 gt = acc[ai][0][m][n] * rstd + (csv[0][n] * nmr + biv[0][n]), up = acc[ai][1][m][n] * rstd + (csv[1][n] * nmr + biv[1][n]);
#pragma unroll
                    for (int e = 0; e < 4; ++e) o[4 * n + e] = gt[e] * fast_sigmoid(gt[e]) * up[e]; }
                u32x4 w; w.x = cvt_pk_bf16(o[0], o[1]); w.y = cvt_pk_bf16(o[2], o[3]); w.z = cvt_pk_bf16(o[4], o[5]); w.w = cvt_pk_bf16(o[6], o[7]);
                *(u32x4*)(rowp) = w; } }
    }
};

template <class Epi, class Sched, bool ALIGN_EPI = false, bool SP2 = false, bool F16 = false>
__device__ __forceinline__ void gemm_phase(PG8_LAS unsigned char* lds, const Gemm g, const Sched& S, const Epi& E) {
    int tid_ = threadIdx.x; asm volatile("" : "+v"(tid_)); const int tid = tid_, wid = __builtin_amdgcn_readfirstlane(tid >> 6), lane = tid & 63, wr = wid >> 2, wc = wid & 3, fr = lane & 15, fq = lane >> 4;
    const int K = g.K, nt = K / BK;
    unsigned voffA[2], voffB[2];
#pragma unroll
    for (int i = 0; i < 2; ++i) { int R, C; stage_rc(tid * 16 + i * 8192, R, C); const int Rb = Epi::PERM ? ((R & ~31) + perm32(R & 31)) : R;
        voffA[i] = (unsigned)(R * K + C) * 2u; voffB[i] = (unsigned)(Rb * K + C) * 2u; }
    const size_t kstep = (size_t)(BK * 2);
    const size_t hstep = (size_t)HALF * K * 2;
    const size_t tstep = 2 * hstep;
    const unsigned ldsw = (unsigned)wid * 1024u;
    const int aoff = lds_byte(wr * 64 + fr, fq * 8), boff = lds_byte(wc * 32 + fr, fq * 8);
#define PG8_SA(b, h) (((b) * 2 + (h)) * HTB)
#define PG8_SB(b, h) ((4 + (b) * 2 + (h)) * HTB)
#define PG8_STAGE(bufoff, gbase, voff) do { _Pragma("unroll") for (int _i = 0; _i < 2; ++_i) \
        __builtin_amdgcn_global_load_lds((const unsigned*)((const char*)(gbase) + (voff)[_i]), (PG8_LAS unsigned*)(lds + (bufoff) + ldsw + _i * 8192), 16, 0, 0); } while (0)
#define PG8_LDA(dst, b, h) do { _Pragma("unroll") for (int m = 0; m < 4; ++m) _Pragma("unroll") for (int k = 0; k < 2; ++k) dst[m][k] = *(const PG8_LAS bf16x8*)(lds + PG8_SA(b, h) + aoff + m * 2048 + k * 1024); } while (0)
#define PG8_LDB(dst, b, h) do { _Pragma("unroll") for (int n = 0; n < 2; ++n) _Pragma("unroll") for (int k = 0; k < 2; ++k) dst[n][k] = *(const PG8_LAS bf16x8*)(lds + PG8_SB(b, h) + boff + n * 2048 + k * 1024); } while (0)
#define PG8_MMA(ai, bj, At, Bt) do { __builtin_amdgcn_s_setprio(1); _Pragma("unroll") for (int m = 0; m < 4; ++m) _Pragma("unroll") for (int n = 0; n < 2; ++n) _Pragma("unroll") for (int k = 0; k < 2; ++k) \
        acc[ai][bj][m][n] = mma16<F16>(Bt[n][k], At[m][k], acc[ai][bj][m][n]); __builtin_amdgcn_s_setprio(0); } while (0)
#define PG8_WAIT_V(n) asm volatile("s_waitcnt vmcnt(" #n ")" ::: "memory")
#define PG8_WAIT_L(n) asm volatile("s_waitcnt lgkmcnt(" #n ")" ::: "memory")
#define PG8_BAR __builtin_amdgcn_s_barrier()
#define PG8_SCHED __builtin_amdgcn_sched_barrier(0)
    Unit cur, nxt; int ui = 0;
    if (!S.next(0, cur)) return;
    f32x4 acc[2][2][4][2];
    E.init(acc, cur, wr, wc, fr, fq);
    bf16x8 At[4][2], B0[2][2], B1[2][2];
    const char* cA = (const char*)g.A + (size_t)cur.pm * tstep; const char* cB = (const char*)(cur.pm >= g.mb ? g.Bt1 : g.Bt) + (size_t)cur.pn * tstep;
    S.a_ready(cur);
    if constexpr (SP2) {
        PG8_STAGE(PG8_SB(0, 0), cB, voffB); PG8_STAGE(PG8_SB(0, 1), cB + hstep, voffB); PG8_STAGE(PG8_SA(0, 0), cA, voffA); PG8_STAGE(PG8_SA(0, 1), cA + hstep, voffA);
        if (wr == 1) PG8_BAR;
        PG8_WAIT_V(2); PG8_BAR;
        PG8_STAGE(PG8_SB(1, 0), cB + kstep, voffB); PG8_STAGE(PG8_SA(1, 0), cA + kstep, voffA); PG8_STAGE(PG8_SB(1, 1), cB + hstep + kstep, voffB);
        PG8_WAIT_V(6); PG8_BAR;
    } else {
        PG8_STAGE(PG8_SB(0, 0), cB, voffB); PG8_STAGE(PG8_SA(0, 0), cA, voffA); PG8_STAGE(PG8_SB(0, 1), cB + hstep, voffB); PG8_STAGE(PG8_SA(0, 1), cA + hstep, voffA);
        if (wr == 1) PG8_BAR;
        PG8_WAIT_V(4); PG8_BAR;
        PG8_STAGE(PG8_SB(1, 0), cB + kstep, voffB); PG8_STAGE(PG8_SA(1, 0), cA + kstep, voffA); PG8_STAGE(PG8_SB(1, 1), cB + hstep + kstep, voffB);
        PG8_WAIT_V(6); PG8_BAR;
    }
    for (;;) {
        const bool has_next = S.next(ui + 1, nxt);
        const char* nA = has_next ? (const char*)g.A + (size_t)nxt.pm * tstep : cA; const char* nB = has_next ? (const char*)(nxt.pm >= g.mb ? g.Bt1 : g.Bt) + (size_t)nxt.pn * tstep : cB;
        for (int t = 0; t < nt; t += 2) {
            const bool last = (t == nt - 2);
            const char* a1 = cA + (size_t)(t + 1) * kstep;
            const char* a2 = last ? nA : cA + (size_t)(t + 2) * kstep; const char* b2 = last ? nB : cB + (size_t)(t + 2) * kstep;
            const char* a3 = a2 + kstep; const char* b3 = b2 + kstep;
            if (last && has_next) S.a_ready(nxt);
            if (last) E.prefetch(cur, wid, wc, lane);
            if constexpr (SP2) {
            PG8_LDB(B0, 0, 0); PG8_LDB(B1, 0, 1); PG8_SCHED; PG8_LDA(At, 0, 0); PG8_STAGE(PG8_SA(1, 1), a1 + hstep, voffA);
            PG8_WAIT_V(8); PG8_WAIT_L(0); PG8_BAR; PG8_MMA(0, 0, At, B0); PG8_MMA(0, 1, At, B1); PG8_BAR; PG8_SCHED;
            PG8_LDA(At, 0, 1); PG8_STAGE(PG8_SB(0, 0), b2, voffB); PG8_STAGE(PG8_SB(0, 1), b2 + hstep, voffB); PG8_STAGE(PG8_SA(0, 0), a2, voffA);
            PG8_WAIT_V(8); PG8_WAIT_L(0); PG8_BAR; PG8_MMA(1, 0, At, B0); PG8_MMA(1, 1, At, B1); PG8_BAR; PG8_SCHED;
            PG8_LDB(B0, 1, 0); PG8_LDB(B1, 1, 1); PG8_SCHED; PG8_LDA(At, 1, 0); PG8_STAGE(PG8_SA(0, 1), a2 + hstep, voffA);
            PG8_WAIT_V(8); PG8_WAIT_L(0); PG8_BAR; PG8_MMA(0, 0, At, B0); PG8_MMA(0, 1, At, B1); PG8_BAR; PG8_SCHED;
            PG8_LDA(At, 1, 1); PG8_STAGE(PG8_SB(1, 0), b3, voffB); PG8_STAGE(PG8_SB(1, 1), b3 + hstep, voffB); PG8_STAGE(PG8_SA(1, 0), a3, voffA);
            PG8_WAIT_V(8); PG8_WAIT_L(0); PG8_BAR; PG8_MMA(1, 0, At, B0); PG8_MMA(1, 1, At, B1); PG8_BAR; PG8_SCHED;
            } else {
            PG8_LDB(B0, 0, 0); PG8_SCHED; PG8_LDA(At, 0, 0); PG8_STAGE(PG8_SA(1, 1), a1 + hstep, voffA);
            PG8_WAIT_L(8); PG8_BAR; PG8_WAIT_L(0); PG8_MMA(0, 0, At, B0); PG8_BAR; PG8_SCHED;
            PG8_LDB(B1, 0, 1); PG8_STAGE(PG8_SB(0, 0), b2, voffB);
            PG8_BAR; PG8_WAIT_L(0); PG8_MMA(0, 1, At, B1); PG8_BAR;
            PG8_LDA(At, 0, 1); PG8_STAGE(PG8_SA(0, 0), a2, voffA);
            PG8_BAR; PG8_WAIT_L(0); PG8_MMA(1, 0, At, B0); PG8_BAR; PG8_SCHED;
            PG8_STAGE(PG8_SB(0, 1), b2 + hstep, voffB);
            PG8_WAIT_V(6); PG8_BAR; PG8_MMA(1, 1, At, B1); PG8_BAR;
            PG8_LDB(B0, 1, 0); PG8_SCHED; PG8_LDA(At, 1, 0); PG8_STAGE(PG8_SA(0, 1), a2 + hstep, voffA);
            PG8_WAIT_L(8); PG8_BAR; PG8_WAIT_L(0); PG8_MMA(0, 0, At, B0); PG8_BAR; PG8_SCHED;
            PG8_LDB(B1, 1, 1); PG8_STAGE(PG8_SB(1, 0), b3, voffB);
            PG8_BAR; PG8_WAIT_L(0); PG8_MMA(0, 1, At, B1); PG8_BAR;
            PG8_LDA(At, 1, 1); PG8_STAGE(PG8_SA(1, 0), a3, voffA);
            PG8_BAR; PG8_WAIT_L(0); PG8_MMA(1, 0, At, B0); PG8_BAR; PG8_SCHED;
            PG8_STAGE(PG8_SB(1, 1), b3 + hstep, voffB);
            PG8_WAIT_V(6); PG8_BAR; PG8_MMA(1, 1, At, B1); PG8_BAR;
            }
        }
        if constexpr (ALIGN_EPI) { if (wr == 0) PG8_BAR; }
        if constexpr (!Epi::AFTER_DRAIN) { E(acc, cur, wr, wc, fr, fq); S.done(cur); }
        if (!has_next) break;
        E.init(acc, nxt, wr, wc, fr, fq);
        cur = nxt; cA = nA; cB = nB; ++ui;
        if constexpr (ALIGN_EPI) { if (wr == 1) PG8_BAR; }
    }
    PG8_WAIT_V(0);
    if constexpr (!ALIGN_EPI) { if (wr == 0) PG8_BAR; }
    PG8_BAR;
    if constexpr (Epi::AFTER_DRAIN) { E.fused(acc, cur, wr, wc, fr, fq, lds, wid, lane); S.done(cur); }
#undef PG8_SA
#undef PG8_SB
#undef PG8_STAGE
#undef PG8_LDA
#undef PG8_LDB
#undef PG8_MMA
#undef PG8_WAIT_V
#undef PG8_WAIT_L
#undef PG8_BAR
#undef PG8_SCHED
}
}

#define LAS __attribute__((address_space(3)))
typedef unsigned short bf16;
typedef unsigned v4u __attribute__((ext_vector_type(4)));
typedef unsigned v2u __attribute__((ext_vector_type(2)));
typedef float f32x4 __attribute__((ext_vector_type(4)));
typedef float f32x16 __attribute__((ext_vector_type(16)));
typedef short bf16x8 __attribute__((ext_vector_type(8)));
typedef short v4i16_t __attribute__((ext_vector_type(4)));
using pg8::cvt_pk_bf16; using pg8::bf_lo; using pg8::bf_hi; using pg8::pk_f16; using pg8::h_lo; using pg8::h_hi;

#define XB_TMO      128
#define XB_XCNT(j)  (256  + 64 * (j))
#define XB_XSUB(j)  (1280 + 64 * (j))
#define XB_XGEN(j)  (2304 + 64 * (j))
#define XB_TOP      3328
#define XB_TOPGEN   3392
#define XCD_BAR_WORDS 3456
#define XB_SPIN_CAP (1u << 18)

__device__ __forceinline__ unsigned xb_ld(unsigned* p)              { return __hip_atomic_load(p, __ATOMIC_RELAXED, __HIP_MEMORY_SCOPE_AGENT); }
__device__ __forceinline__ unsigned xb_add(unsigned* p, unsigned v) { return __hip_atomic_fetch_add(p, v, __ATOMIC_RELAXED, __HIP_MEMORY_SCOPE_AGENT); }
__device__ __forceinline__ unsigned xb_xcc_id() { return (unsigned)__builtin_amdgcn_s_getreg((3 << 11) | 20) & 0xFu; }
#define XB_SPIN(cond, bar) do { unsigned _sp = 0; while (cond) { __builtin_amdgcn_s_sleep(1); \
    if ((++_sp & 255u) == 0u) { if (xb_ld(&(bar)[XB_TMO])) break; if (_sp > XB_SPIN_CAP) { atomicAdd(&(bar)[XB_TMO], 1u); break; } } } } while (0)

struct XcdBarrier {
    unsigned* bar; unsigned x;
    volatile LAS unsigned* st;
};

__device__ __forceinline__ XcdBarrier xcd_barrier_post(unsigned* bar, volatile LAS unsigned* st) {
    XcdBarrier b; b.bar = bar; b.x = xb_xcc_id(); b.st = st;
    if (threadIdx.x == 0) (void)xb_add(&bar[XB_XCNT(b.x)], 1u);
    return b;
}
__device__ __forceinline__ void xcd_barrier_complete(unsigned* bar, unsigned x, unsigned& nloc, unsigned& nx) {
    const unsigned G = gridDim.x * gridDim.y * gridDim.z;
    unsigned sum, cnt, mine, sp = 0u;
    for (;;) {
        sum = 0u; cnt = 0u; mine = 0u;
#pragma unroll
        for (unsigned j = 0; j < 16; ++j) { const unsigned c = xb_ld(&bar[XB_XCNT(j)]); sum += c; cnt += (c > 0u) ? 1u : 0u; mine = (j == x) ? c : mine; }
        if (sum == G) break;
        __builtin_amdgcn_s_sleep(1);
        if ((++sp & 255u) == 0u) { if (xb_ld(&bar[XB_TMO])) break; if (sp > XB_SPIN_CAP) { atomicAdd(&bar[XB_TMO], 1u); break; } }
    }
    nloc = mine > 0u ? mine : 1u; nx = cnt > 0u ? cnt : 1u;
}

__device__ __forceinline__ void xcd_barrier(const XcdBarrier& b) {
    asm volatile("s_waitcnt vmcnt(0)" ::: "memory");
    __syncthreads();
    if (threadIdx.x == 0) {
        unsigned* bar = b.bar;
        __builtin_amdgcn_s_waitcnt(0);
        unsigned nloc = b.st[0], nx = b.st[1];
        if (nloc == 0u) { xcd_barrier_complete(bar, b.x, nloc, nx); b.st[0] = nloc; b.st[1] = nx; }
        const unsigned old = xb_add(&bar[XB_XSUB(b.x)], 1u);
        const unsigned gen = old / nloc;
        if (old + 1u == (gen + 1u) * nloc) {
            __builtin_amdgcn_fence(__ATOMIC_RELEASE, "agent");
            asm volatile("s_waitcnt vmcnt(0)" ::: "memory");
            const unsigned og = xb_add(&bar[XB_TOP], 1u);
            const unsigned tg = og / nx;
            if (og + 1u == (tg + 1u) * nx) xb_add(&bar[XB_TOPGEN], 1u);
            else XB_SPIN(xb_ld(&bar[XB_TOPGEN]) == tg, bar);
            __builtin_amdgcn_fence(__ATOMIC_ACQUIRE, "agent");
            xb_add(&bar[XB_XGEN(b.x)], 1u);
            asm volatile("s_waitcnt vmcnt(0)" ::: "memory");
        } else {
            XB_SPIN(xb_ld(&bar[XB_XGEN(b.x)]) == gen, bar);
            __builtin_amdgcn_fence(__ATOMIC_ACQUIRE, "agent");
            asm volatile("s_waitcnt vmcnt(0)" ::: "memory");
        }
    }
    __syncthreads();
}


constexpr int NWAVES = 8, NTHREADS = 512;
constexpr int LDS_BYTES = 147456;
constexpr int MISC_OFF = 131072 + 320;
constexpr size_t MiB = 1u << 20;
constexpr size_t WS_MOD = 0;
constexpr size_t WS_BAR = 512 * 1024;
constexpr size_t WS_LSE = 1 * MiB;
constexpr size_t WS_W = 3 * MiB;
constexpr size_t W_IN = 0, W_IN1 = 10 * MiB, W_A = 20 * MiB, W_B = 21 * MiB, W_O = 22 * MiB, W_GU = 24 * MiB, W_GU1 = 35 * MiB, W_D = 46 * MiB;
constexpr size_t WS_VEC = 55 * MiB;
constexpr int VEC_LAYER = 2 * 2 * 5120 + 2 * 2 * 5632, V_CS_IN = 0, V_BI_IN = 2 * 5120, V_CS_GU = 4 * 5120, V_BI_GU = 4 * 5120 + 2 * 5632;
constexpr size_t WS_STAT1 = 56 * MiB, WS_STAT2 = 60 * MiB;
constexpr size_t WS_ZB = 64 * MiB;
constexpr size_t WS_YA = 128 * MiB;
constexpr size_t WS_YB = 160 * MiB;
constexpr size_t WS_QKV = 176 * MiB;
constexpr size_t WS_ZLO = 368 * MiB;
constexpr size_t WS_OG = 432 * MiB;
constexpr size_t WS_W2 = 496 * MiB;
constexpr size_t W2_O1 = 0, W2_D1 = 2 * MiB;
constexpr size_t WS_END = 504 * MiB;
constexpr int QKVW = 3072;

struct Params {
    const float *x, *c, *w_ada, *b_ada, *w_in, *sinks, *w_a, *w_b, *w_o, *ln1_g, *ln1_b, *w_gate, *w_up, *w_down, *ln2_g, *ln2_b;
    float* out; unsigned char* ws;
};

__device__ __forceinline__ int opaque_tid() { int t = threadIdx.x; asm volatile("" : "+v"(t)); return t; }
__device__ __forceinline__ float wave_sum(float v) {
#pragma unroll
    for (int o = 1; o < 64; o <<= 1) v += __shfl_xor(v, o);
    return v;
}

__device__ __forceinline__ void phase_mods(const Params& P, unsigned char* lds) {
    float* red = (float*)lds;
    float* mod = (float*)(P.ws + WS_MOD);
    const int tid = opaque_tid(), kg = tid >> 4, cl = tid & 15;
    for (int item = blockIdx.x; item < DEPTH * 96; item += gridDim.x) {
        const int l = item / 96, j0 = (item % 96) * 64;
        const float* w = P.w_ada + (size_t)l * DM * 6 * DM + j0 + 4 * cl;
        f32x4 a0 = {0.f, 0.f, 0.f, 0.f}, a1 = {0.f, 0.f, 0.f, 0.f};
#pragma unroll 8
        for (int kk = 0; kk < 32; ++kk) { const int k = kg * 32 + kk;
            const f32x4 wv = *(const f32x4*)(w + (size_t)k * 6 * DM);
            const float c0 = P.c[k], c1 = P.c[DM + k];
            const float s0 = c0 / (1.f + __expf(-c0)), s1 = c1 / (1.f + __expf(-c1));
            a0 += wv * s0; a1 += wv * s1; }
        float* rp = red + (kg * 16 + cl) * 8;
        rp[0] = a0[0]; rp[1] = a0[1]; rp[2] = a0[2]; rp[3] = a0[3]; rp[4] = a1[0]; rp[5] = a1[1]; rp[6] = a1[2]; rp[7] = a1[3];
        __syncthreads();
        if (tid < 128) { const int c2 = tid >> 3, i = tid & 7; float s = 0.f;
#pragma unroll 8
            for (int g = 0; g < 32; ++g) s += red[(g * 16 + c2) * 8 + i];
            const int b = i >> 2, col = j0 + 4 * c2 + (i & 3);
            mod[(size_t)(l * 2 + b) * 6 * DM + col] = s + P.b_ada[(size_t)l * 6 * DM + col]; }
        __syncthreads();
    }
}

struct Fold { const float* g; const float* b; const float* m0; const float* m1; int sc, sh; };
__device__ __forceinline__ float bf_round(float f) { unsigned u = __builtin_bit_cast(unsigned, f); u = (u + 0x7fffu + ((u >> 16) & 1u)) & 0xffff0000u; return __uint_as_float(u); }

__device__ __forceinline__ void phase_vecs(const Params& P, unsigned char* lds) {
    float* red = (float*)lds;
    const float* mod = (const float*)(P.ws + WS_MOD);
    float* vec = (float*)(P.ws + WS_VEC);
    const int tid = opaque_tid(), kg = tid >> 4, cl = tid & 15;
    for (int item = blockIdx.x; item < DEPTH * 168; item += gridDim.x) {
        const int l = item / 168, r = item % 168;
        const float* W; int N, j0, mat; Fold F; F.m0 = mod + (size_t)l * 12 * DM; F.m1 = F.m0 + 6 * DM;
        if (r < 80) { mat = 0; W = P.w_in + (size_t)l * DM * INW; N = INW; j0 = r * 64; F.g = l ? P.ln2_g + (l - 1) * DM : nullptr; F.b = l ? P.ln2_b + (l - 1) * DM : nullptr; F.sc = 1 * DM; F.sh = 0; }
        else { mat = 1 + (r - 80) / 44; W = (mat == 1 ? P.w_gate : P.w_up) + (size_t)l * DM * DFF; N = DFF; j0 = ((r - 80) % 44) * 64; F.g = P.ln1_g + l * DM; F.b = P.ln1_b + l * DM; F.sc = 4 * DM; F.sh = 3 * DM; }
        const float* w = W + j0 + 4 * cl;
        f32x4 a0 = {0.f, 0.f, 0.f, 0.f}, a1 = a0, a2 = a0, a3 = a0;
#pragma unroll 4
        for (int kk = 0; kk < 32; ++kk) { const int k = kg * 32 + kk;
            const f32x4 wv = *(const f32x4*)(w + (size_t)k * N);
            const float gp = F.g ? F.g[k] : 1.f, bp = F.b ? F.b[k] : 0.f;
            const float s0 = 1.f + F.m0[F.sc + k], s1 = 1.f + F.m1[F.sc + k];
            const float g0 = gp * s0, g1 = gp * s1, b0 = bp * s0 + F.m0[F.sh + k], b1 = bp * s1 + F.m1[F.sh + k];
#pragma unroll
            for (int e = 0; e < 4; ++e) { a0[e] += (float)(_Float16)(g0 * wv[e]); a1[e] += (float)(_Float16)(g1 * wv[e]); }
            a2 += wv * b0; a3 += wv * b1; }
        float* rp = red + (kg * 16 + cl) * 16;
        *(f32x4*)(rp) = a0; *(f32x4*)(rp + 4) = a1; *(f32x4*)(rp + 8) = a2; *(f32x4*)(rp + 12) = a3;
        __syncthreads();
        if (tid < 256) { const int c2 = tid >> 4, i = tid & 15; float s = 0.f;
#pragma unroll 8
            for (int g = 0; g < 32; ++g) s += red[(g * 16 + c2) * 16 + i];
            const int which = i >> 2, col = j0 + 4 * c2 + (i & 3), b = which & 1;
            float* vl = vec + (size_t)l * VEC_LAYER;
            if (mat == 0) vl[(which < 2 ? V_CS_IN : V_BI_IN) + b * 5120 + col] = s;
            else { const int tr = (col >> 7) * 256 + (col & 127) + (mat == 2 ? 128 : 0); vl[(which < 2 ? V_CS_GU : V_BI_GU) + b * 5632 + tr] = s; } }
        __syncthreads();
    }
}

__device__ __forceinline__ unsigned f2bf(float f) { unsigned u = __builtin_bit_cast(unsigned, f); return (u + 0x7fffu + ((u >> 16) & 1u)) >> 16; }
__device__ __forceinline__ unsigned pk2(float lo, float hi) { return f2bf(lo) | (f2bf(hi) << 16); }
template <int FOLD>
__device__ __forceinline__ void transpose_item(const float* W, int K, int N, bf16* WT0, bf16* WT1, const Fold& F, int mode, float* scr, int item, int lane) {
    const int nblk = N / 32, kb = item / nblk, nb = item % nblk, k0 = 64 * kb, n0 = 32 * nb;
    const int drow0 = (mode == 0) ? n0 : ((n0 >> 7) * 256 + (n0 & 127) + (mode == 2 ? 128 : 0));
#pragma unroll 8
    for (int i = 0; i < 32; ++i) { const int kk = 2 * i + (lane >> 5); scr[kk * 33 + (lane & 31)] = W[(size_t)(k0 + kk) * N + n0 + (lane & 31)]; }
    const int c = lane & 7;
    float g0[8], g1[8];
    if (FOLD == 1) {
#pragma unroll
        for (int i = 0; i < 8; ++i) { const int k = k0 + 8 * c + i; const float gp = F.g ? F.g[k] : 1.f; g0[i] = gp * (1.f + F.m0[F.sc + k]); g1[i] = gp * (1.f + F.m1[F.sc + k]); } }
    float h0[4], h1[4];
    if (FOLD == 2) {
#pragma unroll
        for (int j = 0; j < 4; ++j) { const int n = n0 + (lane >> 3) + 8 * j; h0[j] = F.m0[F.sc + n]; h1[j] = F.m1[F.sc + n]; } }
    asm volatile("s_waitcnt lgkmcnt(0)" ::: "memory");
#pragma unroll
    for (int j = 0; j < 4; ++j) { const int n = (lane >> 3) + 8 * j; const float* s = scr + (8 * c) * 33 + n;
        float v[8];
#pragma unroll
        for (int i = 0; i < 8; ++i) v[i] = s[i * 33];
        if (FOLD == 2) {
#pragma unroll
            for (int i = 0; i < 8; ++i) { g0[i] = h0[j]; g1[i] = h1[j]; } }
        if (FOLD == 1) {
            v4u o; o.x = pk_f16(v[0] * g0[0], v[1] * g0[1]); o.y = pk_f16(v[2] * g0[2], v[3] * g0[3]); o.z = pk_f16(v[4] * g0[4], v[5] * g0[5]); o.w = pk_f16(v[6] * g0[6], v[7] * g0[7]);
            *(v4u*)(WT0 + (size_t)(drow0 + n) * K + k0 + 8 * c) = o;
            v4u p; p.x = pk_f16(v[0] * g1[0], v[1] * g1[1]); p.y = pk_f16(v[2] * g1[2], v[3] * g1[3]); p.z = pk_f16(v[4] * g1[4], v[5] * g1[5]); p.w = pk_f16(v[6] * g1[6], v[7] * g1[7]);
            *(v4u*)(WT1 + (size_t)(drow0 + n) * K + k0 + 8 * c) = p;
        } else if (FOLD == 2) {
            v4u o; o.x = pk2(v[0] * g0[0], v[1] * g0[1]); o.y = pk2(v[2] * g0[2], v[3] * g0[3]); o.z = pk2(v[4] * g0[4], v[5] * g0[5]); o.w = pk2(v[6] * g0[6], v[7] * g0[7]);
            *(v4u*)(WT0 + (size_t)(drow0 + n) * K + k0 + 8 * c) = o;
            v4u p; p.x = pk2(v[0] * g1[0], v[1] * g1[1]); p.y = pk2(v[2] * g1[2], v[3] * g1[3]); p.z = pk2(v[4] * g1[4], v[5] * g1[5]); p.w = pk2(v[6] * g1[6], v[7] * g1[7]);
            *(v4u*)(WT1 + (size_t)(drow0 + n) * K + k0 + 8 * c) = p;
        } else {
            v4u o; o.x = pk2(v[0], v[1]); o.y = pk2(v[2], v[3]); o.z = pk2(v[4], v[5]); o.w = pk2(v[6], v[7]);
            *(v4u*)(WT0 + (size_t)(drow0 + n) * K + k0 + 8 * c) = o; } }
    asm volatile("s_waitcnt lgkmcnt(0)" ::: "memory");
}
__device__ __forceinline__ void phase_weights(const Params& P, int l, unsigned char* lds) {
    const int tid = opaque_tid(), lane = tid & 63, wave = tid >> 6;
    float* scr = (float*)(lds + wave * 16384);
    unsigned char* Wb = P.ws + WS_W;
    const float* mod = (const float*)(P.ws + WS_MOD);
    Fold Fi, Fg, Fn{}; Fi.m0 = mod + (size_t)l * 12 * DM; Fi.m1 = Fi.m0 + 6 * DM; Fi.g = l ? P.ln2_g + (l - 1) * DM : nullptr; Fi.b = nullptr; Fi.sc = 1 * DM; Fi.sh = 0;
    Fg = Fi; Fg.g = P.ln1_g + l * DM; Fg.sc = 4 * DM; Fg.sh = 3 * DM;
    Fold Fo = Fi, Fd = Fi; Fo.sc = 2 * DM; Fd.sc = 5 * DM;
    constexpr int I_IN = 16 * 160, I_A = 8 * 32, I_B = 4 * 32, I_O = 16 * 32, I_G = 16 * 88, I_D = 44 * 32;
    constexpr int NITEMS = I_IN + I_A + I_B + I_O + 2 * I_G + I_D;
    const int gw = blockIdx.x * NWAVES + wave, NGW = gridDim.x * NWAVES;
    for (int it = gw; it < NITEMS; it += NGW) {
        int r = it;
        if (r < I_IN) { transpose_item<1>(P.w_in + (size_t)l * DM * INW, DM, INW, (bf16*)(Wb + W_IN), (bf16*)(Wb + W_IN1), Fi, 0, scr, r, lane); continue; } r -= I_IN;
        if (r < I_G) { transpose_item<1>(P.w_gate + (size_t)l * DM * DFF, DM, DFF, (bf16*)(Wb + W_GU), (bf16*)(Wb + W_GU1), Fg, 1, scr, r, lane); continue; } r -= I_G;
        if (r < I_G) { transpose_item<1>(P.w_up + (size_t)l * DM * DFF, DM, DFF, (bf16*)(Wb + W_GU), (bf16*)(Wb + W_GU1), Fg, 2, scr, r, lane); continue; } r -= I_G;
        if (r < I_A) { transpose_item<0>(P.w_a + (size_t)l * 512 * DM, 512, DM, (bf16*)(Wb + W_A), nullptr, Fn, 0, scr, r, lane); continue; } r -= I_A;
        if (r < I_B) { transpose_item<0>(P.w_b + (size_t)l * 256 * DM, 256, DM, (bf16*)(Wb + W_B), nullptr, Fn, 0, scr, r, lane); continue; } r -= I_B;
        if (r < I_O) { transpose_item<2>(P.w_o + (size_t)l * DM * DM, DM, DM, (bf16*)(Wb + W_O), (bf16*)(P.ws + WS_W2 + W2_O1), Fo, 0, scr, r, lane); continue; } r -= I_O;
        transpose_item<2>(P.w_down + (size_t)l * DFF * DM, DFF, DM, (bf16*)(Wb + W_D), (bf16*)(P.ws + WS_W2 + W2_D1), Fd, 0, scr, r, lane);
    }
}

__device__ __forceinline__ void phase_x2bf16(const float* src, bf16* dst) {
    const int n4 = NTOK * DM / 4, nth = gridDim.x * NTHREADS;
    for (int i = blockIdx.x * NTHREADS + opaque_tid(); i < n4 / 2; i += nth) { const f32x4 a = ((const f32x4*)src)[2 * i], c = ((const f32x4*)src)[2 * i + 1]; v4u w; w.x = pk_f16(a.x, a.y); w.y = pk_f16(a.z, a.w); w.z = pk_f16(c.x, c.y); w.w = pk_f16(c.z, c.w); ((v4u*)dst)[i] = w; }
}

template <bool DO_LN, bool WRITE_X, bool WRITE_U>
__device__ __forceinline__ void phase_rows(const float* src, float* xdst, bf16* udst, const float* gamma, const float* beta, const float* modl, int sc_off, int sh_off) {
    const int tid = opaque_tid(), lane = tid & 63, wave = tid >> 6;
    const int gw = blockIdx.x * NWAVES + wave, NGW = gridDim.x * NWAVES;
    for (int m = gw; m < NTOK; m += NGW) {
        const f32x4* xr = (const f32x4*)(src + (size_t)m * DM) + lane;
        f32x4 v[4];
#pragma unroll
        for (int j = 0; j < 4; ++j) v[j] = xr[64 * j];
        if (DO_LN) {
            float s = 0.f;
#pragma unroll
            for (int j = 0; j < 4; ++j) s += (v[j].x + v[j].y) + (v[j].z + v[j].w);
            const float mean = wave_sum(s) * (1.f / DM); float s2 = 0.f;
#pragma unroll
            for (int j = 0; j < 4; ++j) { v[j] = v[j] - mean; s2 += (v[j].x * v[j].x + v[j].y * v[j].y) + (v[j].z * v[j].z + v[j].w * v[j].w); }
            const float rstd = 1.f / sqrtf(wave_sum(s2) * (1.f / DM) + LN_EPS);
#pragma unroll
            for (int j = 0; j < 4; ++j) { const f32x4 g = ((const f32x4*)gamma)[lane + 64 * j], b = ((const f32x4*)beta)[lane + 64 * j]; v[j] = v[j] * rstd * g + b; }
        }
        if (WRITE_X) { f32x4* xo = (f32x4*)(xdst + (size_t)m * DM) + lane;
#pragma unroll
            for (int j = 0; j < 4; ++j) xo[64 * j] = v[j]; }
        if (WRITE_U) { const float* mb = modl + (m >= SEQ ? 6 * DM : 0); v2u* uo = (v2u*)(udst + (size_t)m * DM) + lane;
#pragma unroll
            for (int j = 0; j < 4; ++j) { const f32x4 sc = ((const f32x4*)(mb + sc_off))[lane + 64 * j], sh = ((const f32x4*)(mb + sh_off))[lane + 64 * j];
                const f32x4 uu = v[j] * (sc + 1.0f) + sh; v2u w; w.x = cvt_pk_bf16(uu.x, uu.y); w.y = cvt_pk_bf16(uu.z, uu.w); uo[64 * j] = w; } }
    }
}

__device__ __forceinline__ void phase_final_ln(const bf16* zh, float* out, const float* gamma, const float* beta) {
    const int tid = opaque_tid(), lane = tid & 63, wave = tid >> 6;
    const int gw = blockIdx.x * NWAVES + wave, NGW = gridDim.x * NWAVES;
    for (int m = gw; m < NTOK; m += NGW) {
        const v4u* hr = (const v4u*)(zh + (size_t)m * DM) + lane;
        f32x4 v[4]; float s = 0.f;
#pragma unroll
        for (int j = 0; j < 2; ++j) { const v4u h = hr[64 * j];
            v[2 * j] = (f32x4){h_lo(h.x), h_hi(h.x), h_lo(h.y), h_hi(h.y)}; v[2 * j + 1] = (f32x4){h_lo(h.z), h_hi(h.z), h_lo(h.w), h_hi(h.w)}; }
#pragma unroll
        for (int j = 0; j < 4; ++j) s += (v[j].x + v[j].y) + (v[j].z + v[j].w);
        const float mean = wave_sum(s) * (1.f / DM); float s2 = 0.f;
#pragma unroll
        for (int j = 0; j < 4; ++j) { v[j] = v[j] - mean; s2 += (v[j].x * v[j].x + v[j].y * v[j].y) + (v[j].z * v[j].z + v[j].w * v[j].w); }
        const float rstd = 1.f / sqrtf(wave_sum(s2) * (1.f / DM) + LN_EPS);
        f32x4* xo = (f32x4*)(out + (size_t)m * DM);
#pragma unroll
        for (int j = 0; j < 4; ++j) { const int e4 = (j >> 1) * 128 + 2 * lane + (j & 1);
            const f32x4 g = ((const f32x4*)gamma)[e4], b = ((const f32x4*)beta)[e4]; xo[e4] = v[j] * rstd * g + b; }
    }
}

constexpr int KV_STRIDE = 144;
constexpr int KV_ROWS = 384;
constexpr int V_STRIDE = 192;
constexpr int LDS_K = 0, LDS_V = KV_ROWS * KV_STRIDE;
__device__ __forceinline__ v4i16_t tr_read(const LAS unsigned char* p) { return __builtin_amdgcn_ds_read_tr16_b64_v4i16((LAS v4i16_t*)p); }

struct AttnU { int b, d, r, n0, nrows, kcol, vcol, qcol, q0, sidx, maxdist, opitch, ocol, lse_idx; int is_a; };
__device__ __forceinline__ AttnU attn_decode(int u, int wave) {
    AttnU A;
    if (u < 1536) {
        const int blk = u & 63, t = u >> 6; A.b = t / 12; const int g = (t % 12) >> 2, j = t & 3;
        A.d = 1 << (2 * g); const int nblk = 64 >> (2 * g); A.r = blk / nblk; A.n0 = (blk % nblk) * 256; A.nrows = 384;
        A.kcol = KB_OFF + g * 256 + j * 64; A.vcol = VB_OFF + g * 256 + j * 64; A.qcol = QB_OFF + g * 256 + j * 64; A.q0 = A.n0 + 32 * wave;
        A.sidx = 8 + 4 * g + j; A.maxdist = 128; A.opitch = 768; A.ocol = g * 256 + j * 64; A.lse_idx = g * 4 + j; A.is_a = 0;
    } else {
        const int ua = u - 1536, blk = ua & 255, t = ua >> 8; A.b = t >> 1; const int kvh = t & 1; A.d = 1; A.r = 0; A.n0 = blk * 64; A.nrows = 192;
        A.kcol = KA_OFF + kvh * 64; A.vcol = VA_OFF + kvh * 64; const int head = kvh * 4 + (wave >> 1); A.qcol = QA_OFF + head * 64; A.q0 = A.n0 + 32 * (wave & 1);
        A.sidx = head; A.maxdist = 127; A.opitch = 512; A.ocol = head * 64; A.lse_idx = -1; A.is_a = 1;
    }
    return A;
}
__device__ __forceinline__ void attn_prefetch(const AttnU& A, const bf16* QKVG, int tid, int r32, int hi, v4u (&kr)[6], v4u (&vr)[6], bf16x8 (&qf)[4]) {
    { const size_t qtok = (size_t)A.b * SEQ + A.r + (size_t)A.d * (A.q0 + r32); const bf16* qp = QKVG + qtok * QKVW + A.qcol + 8 * hi;
#pragma unroll
      for (int d0 = 0; d0 < 4; ++d0) qf[d0] = *(const bf16x8*)(qp + 16 * d0); }
#pragma unroll
    for (int it = 0; it < 6; ++it) { const int c = tid + it * NTHREADS; const int R = c >> 3, ch = c & 7; const int kn = A.n0 - 128 + R;
        kr[it] = (v4u){0u, 0u, 0u, 0u}; vr[it] = (v4u){0u, 0u, 0u, 0u};
        if (R < A.nrows && kn >= 0) { const bf16* src = QKVG + ((size_t)A.b * SEQ + A.r + (size_t)A.d * kn) * QKVW + 8 * ch; kr[it] = *(const v4u*)(src + A.kcol); vr[it] = *(const v4u*)(src + A.vcol); } }
}
#define ATT_BAR() do { asm volatile("s_waitcnt lgkmcnt(0)" ::: "memory"); __builtin_amdgcn_s_barrier(); asm volatile("" ::: "memory"); } while (0)
__device__ __forceinline__ void phase_attention(const Params& P, int layer, LAS unsigned char* lds) {
    const int tid = opaque_tid(), lane = tid & 63, wave = __builtin_amdgcn_readfirstlane(tid >> 6), r32 = lane & 31, hi = lane >> 5;
    const bf16* QKVG = (const bf16*)(P.ws + WS_QKV);
    bf16* OG = (bf16*)(P.ws + WS_OG);
    bf16* YA = (bf16*)(P.ws + WS_YA);
    float* LSE = (float*)(P.ws + WS_LSE);
    const int G = gridDim.x;
    const float sink_lane = P.sinks[layer * 8 + (lane & 7)];
    v4u kr[6], vr[6]; bf16x8 qn[4];
    AttnU N = attn_decode(blockIdx.x, wave);
    if ((int)blockIdx.x < 2560) attn_prefetch(N, QKVG, tid, r32, hi, kr, vr, qn);
    for (int u = blockIdx.x; u < 2560; u += G) {
        const AttnU A = N;
        bf16x8 qf[4];
#pragma unroll
        for (int d0 = 0; d0 < 4; ++d0) qf[d0] = qn[d0];
#pragma unroll
        for (int it = 0; it < 6; ++it) { const int c = tid + it * NTHREADS; const int R = c >> 3, ch = c & 7;
            if (R < A.nrows) { *(LAS v4u*)(lds + LDS_K + R * KV_STRIDE + 16 * ch) = kr[it]; *(LAS v4u*)(lds + LDS_V + R * V_STRIDE + 16 * ch) = vr[it]; } }
        ATT_BAR();
        if (u + G < 2560) { N = attn_decode(u + G, wave); attn_prefetch(N, QKVG, tid, r32, hi, kr, vr, qn); }
        const int b = A.b, d = A.d, r = A.r, n0 = A.n0, q0 = A.q0, maxdist = A.maxdist, lse_idx = A.lse_idx;
        const float m_init = A.is_a ? __uint_as_float(__builtin_amdgcn_readlane(__float_as_uint(sink_lane), A.sidx & 7)) * LOG2E : -1e30f, l_init = (A.is_a && hi == 0) ? 1.f : 0.f;
        bf16* obase = A.is_a ? YA : OG; const int opitch = A.opitch, ocol = A.ocol;
        const float slope2 = exp2f(-8.0f * (float)(A.sidx + 1) / 20.0f) * (float)d * LOG2E;
        float m = m_init, l = l_init; f32x16 o0, o1;
#pragma unroll
        for (int i = 0; i < 16; ++i) { o0[i] = 0.f; o1[i] = 0.f; }
        const int rowb = q0 - n0;
        const int kappa = (r32 & ~12) | ((r32 & 4) << 1) | ((r32 & 8) >> 1);
        const LAS unsigned char* kbase = lds + LDS_K + (rowb + kappa) * KV_STRIDE + 16 * hi;
        const LAS unsigned char* vbase = lds + LDS_V + (rowb + 8 * hi + ((lane & 15) >> 2)) * V_STRIDE + (16 * ((lane >> 4) & 1) + 4 * (lane & 3)) * 2;
#pragma unroll 1
        for (int jt = 0; jt < 5; ++jt) {
            f32x16 S;
#pragma unroll
            for (int i = 0; i < 16; ++i) S[i] = 0.f;
#pragma unroll
            for (int d0 = 0; d0 < 4; ++d0) { const bf16x8 kf = *(const LAS bf16x8*)(kbase + jt * 32 * KV_STRIDE + 32 * d0); S = __builtin_amdgcn_mfma_f32_32x32x16_bf16(kf, qf[d0], S, 0, 0, 0); }
            const int dist0 = r32 + 128 - 32 * jt - 8 * hi, kn0 = q0 - 128 + 32 * jt + 8 * hi;
            float mx = -INFINITY;
            if (jt == 0 || jt == 4 || q0 - 128 + 32 * jt < 0) {
#pragma unroll
                for (int i = 0; i < 16; ++i) { const int off = (i & 7) + 16 * (i >> 3); const int dist = dist0 - off, key = kn0 + off;
                    const bool valid = (dist >= 0) && (dist <= maxdist) && (key >= 0);
                    S[i] = valid ? (S[i] - slope2 * (float)dist) : -INFINITY; mx = fmaxf(mx, S[i]); }
            } else {
                const float base = -slope2 * (float)dist0;
#pragma unroll
                for (int i = 0; i < 16; ++i) { const float off = (float)((i & 7) + 16 * (i >> 3)); S[i] = (S[i] + base) + slope2 * off; mx = fmaxf(mx, S[i]); }
            }
            mx = fmaxf(mx, __shfl_xor(mx, 32));
            const float mn = fmaxf(m, mx), alpha = __builtin_amdgcn_exp2f(m - mn); m = mn;
            float ls = 0.f;
#pragma unroll
            for (int i = 0; i < 16; ++i) { S[i] = __builtin_amdgcn_exp2f(S[i] - mn); ls += S[i]; }
            l = l * alpha + ls;
#pragma unroll
            for (int i = 0; i < 16; ++i) { o0[i] *= alpha; o1[i] *= alpha; }
            bf16x8 pf[2];
#pragma unroll
            for (int s = 0; s < 2; ++s) { v4u w; w.x = cvt_pk_bf16(S[8 * s + 0], S[8 * s + 1]); w.y = cvt_pk_bf16(S[8 * s + 2], S[8 * s + 3]); w.z = cvt_pk_bf16(S[8 * s + 4], S[8 * s + 5]); w.w = cvt_pk_bf16(S[8 * s + 6], S[8 * s + 7]);
                pf[s] = __builtin_bit_cast(bf16x8, w); }
#pragma unroll
            for (int s = 0; s < 2; ++s) {
                const LAS unsigned char* vp = vbase + (jt * 32 + 16 * s) * V_STRIDE;
                const v4i16_t a0 = tr_read(vp), a1 = tr_read(vp + 4 * V_STRIDE), b0 = tr_read(vp + 64), b1 = tr_read(vp + 4 * V_STRIDE + 64);
                const bf16x8 vf0 = (bf16x8){a0[0], a0[1], a0[2], a0[3], a1[0], a1[1], a1[2], a1[3]};
                const bf16x8 vf1 = (bf16x8){b0[0], b0[1], b0[2], b0[3], b1[0], b1[1], b1[2], b1[3]};
                o0 = __builtin_amdgcn_mfma_f32_32x32x16_bf16(vf0, pf[s], o0, 0, 0, 0);
                o1 = __builtin_amdgcn_mfma_f32_32x32x16_bf16(vf1, pf[s], o1, 0, 0, 0);
            }
        }
        l += __shfl_xor(l, 32);
        const float inv = 1.0f / l;
        { const size_t otok = (size_t)b * SEQ + r + (size_t)d * (q0 + r32); bf16* op = obase + otok * opitch + ocol + 4 * hi;
#pragma unroll
          for (int g4 = 0; g4 < 4; ++g4) {
              v2u w0, w1; w0.x = cvt_pk_bf16(o0[4 * g4] * inv, o0[4 * g4 + 1] * inv); w0.y = cvt_pk_bf16(o0[4 * g4 + 2] * inv, o0[4 * g4 + 3] * inv);
              w1.x = cvt_pk_bf16(o1[4 * g4] * inv, o1[4 * g4 + 1] * inv); w1.y = cvt_pk_bf16(o1[4 * g4 + 2] * inv, o1[4 * g4 + 3] * inv);
              *(v2u*)(op + 8 * g4) = w0; *(v2u*)(op + 32 + 8 * g4) = w1; }
          if (lse_idx >= 0 && hi == 0) LSE[otok * 12 + lse_idx] = m + __builtin_amdgcn_logf(l); }
        ATT_BAR();
    }
}

#undef ATT_BAR
__device__ __forceinline__ void phase_combine(const Params& P) {
    const bf16* OG = (const bf16*)(P.ws + WS_OG); bf16* YB = (bf16*)(P.ws + WS_YB); const float* LSE = (const float*)(P.ws + WS_LSE);
    const int nth = gridDim.x * NTHREADS;
    for (int idx = blockIdx.x * NTHREADS + opaque_tid(); idx < NTOK * 32; idx += nth) {
        const int tok = idx >> 5, ch = idx & 31, j = ch >> 3;
        const float l0 = LSE[(size_t)tok * 12 + j], l1 = LSE[(size_t)tok * 12 + 4 + j], l2 = LSE[(size_t)tok * 12 + 8 + j];
        const float M = fmaxf(l0, fmaxf(l1, l2));
        float w0 = __builtin_amdgcn_exp2f(l0 - M), w1 = __builtin_amdgcn_exp2f(l1 - M), w2 = __builtin_amdgcn_exp2f(l2 - M);
        const float inv = 1.0f / (w0 + w1 + w2); w0 *= inv; w1 *= inv; w2 *= inv;
        const bf16* op = OG + (size_t)tok * 768 + ch * 8;
        const v4u a = *(const v4u*)op, b = *(const v4u*)(op + 256), c = *(const v4u*)(op + 512);
        v4u o;
        o.x = cvt_pk_bf16(w0 * bf_lo(a.x) + w1 * bf_lo(b.x) + w2 * bf_lo(c.x), w0 * bf_hi(a.x) + w1 * bf_hi(b.x) + w2 * bf_hi(c.x));
        o.y = cvt_pk_bf16(w0 * bf_lo(a.y) + w1 * bf_lo(b.y) + w2 * bf_lo(c.y), w0 * bf_hi(a.y) + w1 * bf_hi(b.y) + w2 * bf_hi(c.y));
        o.z = cvt_pk_bf16(w0 * bf_lo(a.z) + w1 * bf_lo(b.z) + w2 * bf_lo(c.z), w0 * bf_hi(a.z) + w1 * bf_hi(b.z) + w2 * bf_hi(c.z));
        o.w = cvt_pk_bf16(w0 * bf_lo(a.w) + w1 * bf_lo(b.w) + w2 * bf_lo(c.w), w0 * bf_hi(a.w) + w1 * bf_hi(b.w) + w2 * bf_hi(c.w));
        *(v4u*)(YB + (size_t)tok * 256 + ch * 8) = o;
    }
}

template <bool LN> __device__ __forceinline__ pg8::PanelSlots stage_row_stats(const pg8::StaticOrder& S, const float* stat, LAS unsigned char* L) {
    int p0 = -1, p1 = -1, p2 = -1, p3 = -1, ns = 0;
    pg8::Unit u;
    for (int i = 0; S.next(i, u); ++i) { const int pm = u.pm; if (pm == p0 || pm == p1 || pm == p2 || pm == p3) continue;
        p3 = (ns == 3) ? pm : p3; p2 = (ns == 2) ? pm : p2; p1 = (ns == 1) ? pm : p1; p0 = (ns == 0) ? pm : p0; ++ns; }
    pg8::PanelSlots ps; ps.pm0 = p0; ps.pm1 = p1; ps.pm2 = p2; ps.pm3 = p3;
    if (LN) {
        const int tid = opaque_tid();
        for (int idx = tid; idx < ns * 256; idx += NTHREADS) { const int sl = idx >> 8, r = idx & 255; const int pm = sl == 0 ? ps.pm0 : (sl == 1 ? ps.pm1 : (sl == 2 ? ps.pm2 : ps.pm3));
            const f32x4* p = (const f32x4*)(stat + ((size_t)pm * 256 + r) * 32); float sm = 0.f, q = 0.f;
#pragma unroll
            for (int j = 0; j < 8; ++j) { const f32x4 a = p[j]; sm += a[0] + a[2]; q += a[1] + a[3]; }
            const float mean = sm * (1.0f / 1024.0f), var = q * (1.0f / 1024.0f) - mean * mean, rstd = __builtin_amdgcn_rsqf(var + 1e-5f);
            typedef float f32x2v __attribute__((ext_vector_type(2)));
            *(LAS f32x2v*)(L + pg8::EPI_TAB + idx * 8) = (f32x2v){rstd, -rstd * mean}; }
        __syncthreads();
    }
    return ps;
}

template <int l> __device__ __forceinline__ void layer_body(const Params& P, const XcdBarrier& bar, unsigned char* lds, LAS unsigned char* L, int G, int bid) {
    unsigned char* ws = P.ws;
    const float* modl = (const float*)(ws + WS_MOD) + (size_t)l * 2 * 6 * DM;
    const float* vecl = (const float*)(ws + WS_VEC) + (size_t)l * VEC_LAYER;
    bf16* ZB = (bf16*)(ws + WS_ZB); bf16* YA = (bf16*)(ws + WS_YA); bf16* YB = (bf16*)(ws + WS_YB); bf16* QKV = (bf16*)(ws + WS_QKV); bf16* GATES = (bf16*)P.out; bf16* ZLO = (bf16*)(ws + WS_ZLO);
    bf16* MERGED = QKV; bf16* H = QKV;
    float* STAT1 = (float*)(ws + WS_STAT1); float* STAT2 = (float*)(ws + WS_STAT2);
    { pg8::Gemm g{ZB, (const bf16*)(ws + WS_W + W_IN), NTOK, INW, DM, (const bf16*)(ws + WS_W + W_IN1), 64}; pg8::StaticOrder S; S.init(NTOK, INW, G, bid);
      const pg8::PanelSlots ps = stage_row_stats<(l > 0)>(S, STAT2, L);
      pg8::EpiIn<(l > 0)> E{QKV, GATES, QSCALE, ps.pm0, ps.pm1, ps.pm2, ps.pm3, vecl + V_CS_IN, vecl + V_BI_IN};
      pg8::gemm_phase<pg8::EpiIn<(l > 0)>, pg8::StaticOrder, true, true, true>(L, g, S, E); }
    xcd_barrier(bar);
    phase_attention(P, l, L);
    xcd_barrier(bar);
    phase_combine(P);
    xcd_barrier(bar);
    { const bf16* w = (const bf16*)(ws + WS_W + W_A); pg8::Gemm g{YA, w, NTOK, DM, 512, w, 1 << 30}; pg8::StaticOrder S; S.init(NTOK, DM, G, bid);
      pg8::EpiGate<false> E{MERGED, GATES, 0};
      pg8::gemm_phase<pg8::EpiGate<false>, pg8::StaticOrder, true, true>(L, g, S, E); }
    { const bf16* w = (const bf16*)(ws + WS_W + W_B); pg8::Gemm g{YB, w, NTOK, DM, 256, w, 1 << 30}; pg8::StaticOrder S; S.init(NTOK, DM, G, bid);
      pg8::EpiGate<true> E{MERGED, GATES, 1024};
      pg8::gemm_phase<pg8::EpiGate<true>, pg8::StaticOrder, true, true>(L, g, S, E); }
    xcd_barrier(bar);
    { pg8::Gemm g{MERGED, (const bf16*)(ws + WS_W + W_O), NTOK, DM, DM, (const bf16*)(ws + WS_W2 + W2_O1), 64}; pg8::StaticOrder S; S.init(NTOK, DM, G, bid);
      pg8::EpiRes<(l > 0)> E{P.x, ZB, STAT2, STAT1, P.ln2_g + (l > 0 ? l - 1 : 0) * DM, P.ln2_b + (l > 0 ? l - 1 : 0) * DM, DN_ALPHA};
      pg8::gemm_phase<pg8::EpiRes<(l > 0)>, pg8::StaticOrder, true, true>(L, g, S, E); }
    xcd_barrier(bar);
    { pg8::Gemm g{ZB, (const bf16*)(ws + WS_W + W_GU), NTOK, NGU, DM, (const bf16*)(ws + WS_W + W_GU1), 64}; pg8::StaticOrder S; S.init(NTOK, NGU, G, bid);
      const pg8::PanelSlots ps = stage_row_stats<true>(S, STAT1, L);
      pg8::EpiSwiGLU E{H, ps.pm0, ps.pm1, ps.pm2, ps.pm3, vecl + V_CS_GU, vecl + V_BI_GU};
      pg8::gemm_phase<pg8::EpiSwiGLU, pg8::StaticOrder, true, true, true>(L, g, S, E); }
    xcd_barrier(bar);
    { pg8::Gemm g{H, (const bf16*)(ws + WS_W + W_D), NTOK, DM, DFF, (const bf16*)(ws + WS_W2 + W2_D1), 64}; pg8::StaticOrder S; S.init(NTOK, DM, G, bid);
      pg8::EpiRes<true> E{P.x, ZB, STAT1, STAT2, P.ln1_g + l * DM, P.ln1_b + l * DM, DN_ALPHA};
      pg8::gemm_phase<pg8::EpiRes<true>, pg8::StaticOrder, true, true>(L, g, S, E); }
    xcd_barrier(bar);
    if (l + 1 < DEPTH) { phase_weights(P, l + 1, lds); xcd_barrier(bar); }
    else phase_final_ln(ZB, P.out, P.ln2_g + l * DM, P.ln2_b + l * DM);
}

__global__ void __launch_bounds__(NTHREADS, 2) fwd_megakernel(Params P) {
    extern __shared__ __attribute__((aligned(16))) unsigned char lds[];
    cg::grid_group grid = cg::this_grid();
    LAS unsigned char* L = (LAS unsigned char*)lds;
    const int G = gridDim.x, bid = blockIdx.x;
    unsigned char* ws = P.ws;
    unsigned* barw = (unsigned*)(ws + WS_BAR);
    if (bid == 0) for (int i = threadIdx.x; i < XCD_BAR_WORDS; i += NTHREADS) __hip_atomic_store(barw + i, 0u, __ATOMIC_RELAXED, __HIP_MEMORY_SCOPE_AGENT);
    volatile LAS unsigned* MISC = (volatile LAS unsigned*)(L + MISC_OFF);
    if (threadIdx.x < 32) MISC[threadIdx.x] = 0u;
    __syncthreads();
    phase_mods(P, lds);
    phase_x2bf16(P.x, (bf16*)(ws + WS_ZB));
    grid.sync();
    const XcdBarrier bar = xcd_barrier_post(barw, MISC + 8);
    phase_vecs(P, lds);
    phase_weights(P, 0, lds);
    xcd_barrier(bar);
    layer_body<0>(P, bar, lds, L, G, bid);
    layer_body<1>(P, bar, lds, L, G, bid);
    layer_body<2>(P, bar, lds, L, G, bid);
    layer_body<3>(P, bar, lds, L, G, bid);
}

extern "C" void kernel_launch(void* const* d_in, const int* in_sizes, int n_in, void* d_out, int out_size, void* d_ws, size_t ws_size, hipStream_t stream) {
    static int grid = 0;
    if (grid == 0) {
        if (n_in != 16 || in_sizes[0] != NTOK * DM || out_size != NTOK * DM || ws_size < WS_END) { fprintf(stderr, "kernel_launch: unexpected shapes (n_in %d, in0 %d, out %d, ws %zu)\n", n_in, n_in > 0 ? in_sizes[0] : -1, out_size, ws_size); grid = -1; return; }
        int dev = 0, cus = 0, per_cu = 0;
        hipGetDevice(&dev); hipDeviceGetAttribute(&cus, hipDeviceAttributeMultiprocessorCount, dev);
        hipFuncSetAttribute((const void*)fwd_megakernel, hipFuncAttributeMaxDynamicSharedMemorySize, LDS_BYTES);
        hipOccupancyMaxActiveBlocksPerMultiprocessor(&per_cu, (const void*)fwd_megakernel, NTHREADS, LDS_BYTES);
        (void)hipGetLastError();
        if (per_cu < 1) { fprintf(stderr, "kernel_launch: occupancy query says %d blocks per CU\n", per_cu); per_cu = 1; }
        grid = cus;
    }
    if (grid < 0) return;
    Params p{};
    p.x = (const float*)d_in[0]; p.c = (const float*)d_in[1]; p.w_ada = (const float*)d_in[2]; p.b_ada = (const float*)d_in[3]; p.w_in = (const float*)d_in[4]; p.sinks = (const float*)d_in[5];
    p.w_a = (const float*)d_in[6]; p.w_b = (const float*)d_in[7]; p.w_o = (const float*)d_in[8]; p.ln1_g = (const float*)d_in[9]; p.ln1_b = (const float*)d_in[10];
    p.w_gate = (const float*)d_in[11]; p.w_up = (const float*)d_in[12]; p.w_down = (const float*)d_in[13]; p.ln2_g = (const float*)d_in[14]; p.ln2_b = (const float*)d_in[15];
    p.out = (float*)d_out; p.ws = (unsigned char*)d_ws;
    void* args[] = {&p};
    hipError_t e = hipLaunchCooperativeKernel((const void*)fwd_megakernel, dim3(grid), dim3(NTHREADS), args, LDS_BYTES, stream);
    if (e != hipSuccess) fprintf(stderr, "kernel_launch: cooperative launch failed: %s (grid %d)\n", hipGetErrorString(e), grid);
}
```

```cpp
#include <hip/hip_runtime.h>
#include <hip/hip_cooperative_groups.h>
#include <cstdio>
#include <cstdint>
namespace cg = cooperative_groups;

constexpr int BATCH = 2, SEQ = 16384, DM = 1024, DEPTH = 4, NTOK = BATCH * SEQ;
constexpr int INW = 5120, DFF = 2816, NGU = 2 * DFF;
constexpr int QA_OFF = 0, KA_OFF = 512, VA_OFF = 640, QB_OFF = 768, KB_OFF = 1536, VB_OFF = 2304, GA_OFF = 3072, GB_OFF = 4096;
constexpr float LN_EPS = 1e-5f;
constexpr float DN_ALPHA = 1.681792830507429f;
constexpr float LOG2E = 1.4426950408889634f;
constexpr float QSCALE = 0.125f * LOG2E;

namespace pg8 {
#define PG8_LAS __attribute__((address_space(3)))
typedef unsigned short bf16_t;
typedef short bf16x8 __attribute__((ext_vector_type(8)));
typedef float f32x4 __attribute__((ext_vector_type(4)));
typedef _Float16 f16x8 __attribute__((ext_vector_type(8)));
typedef _Float16 f16x2 __attribute__((ext_vector_type(2)));
template <bool F16> __device__ __forceinline__ f32x4 mma16(bf16x8 a, bf16x8 b, f32x4 c) {
    if constexpr (F16) return __builtin_amdgcn_mfma_f32_16x16x32_f16(__builtin_bit_cast(f16x8, a), __builtin_bit_cast(f16x8, b), c, 0, 0, 0);
    else return __builtin_amdgcn_mfma_f32_16x16x32_bf16(a, b, c, 0, 0, 0);
}
__device__ __forceinline__ unsigned pk_f16(float lo, float hi) { const f16x2 v = {(_Float16)lo, (_Float16)hi}; return __builtin_bit_cast(unsigned, v); }
__device__ __forceinline__ float h_lo(unsigned w) { return (float)__builtin_bit_cast(f16x2, w).x; }
__device__ __forceinline__ float h_hi(unsigned w) { return (float)__builtin_bit_cast(f16x2, w).y; }
typedef unsigned u32x4 __attribute__((ext_vector_type(4)));
constexpr int BM = 256, BK = 64, HALF = 128, HTB = HALF * BK * 2  , STAGE_BYTES = 8 * HTB, NXCD = 8, WGM = 8;

__host__ __device__ __forceinline__ int lds_byte(int r, int c) { const int st = (r >> 4) * 2 + (c >> 5), rr = r & 15, cc = c & 31, ob = rr * 64 + cc * 2; return st * 1024 + (ob ^ (((ob >> 9) & 1) << 5)); }
__host__ __device__ __forceinline__ void stage_rc(int b, int& R, int& C) { const int st = b / 1024, sb = b % 1024, swz = sb ^ (((sb >> 9) & 1) << 5); R = (st >> 1) * 16 + swz / 64; C = (st & 1) * 32 + (swz % 64) / 2; }
__host__ __device__ __forceinline__ int perm32(int rho) { const int n = rho >> 4, i = rho & 15; return 8 * (i >> 2) + 4 * n + (i & 3); }

struct Unit { int pm, pn; };
struct Gemm { const bf16_t* A; const bf16_t* Bt; int M, N, K; const bf16_t* Bt1; int mb; };

struct StaticOrder {
    int nM, nN, nwg, G, c;
    __host__ __device__ void init(int M, int N, int G_, int c_) { nM = M / BM; nN = N / BM; nwg = nM * nN; G = G_; c = c_; }
    __host__ __device__ bool next(int i, Unit& u) const {
        const long L = (long)i * G + c; if (L >= nwg) return false;
        int wgid = (int)L; { const int q = nwg / NXCD, r = nwg % NXCD, xcd = wgid % NXCD, off = wgid / NXCD; wgid = (xcd < r ? xcd * (q + 1) : r * (q + 1) + (xcd - r) * q) + off; }
        const int nig = WGM * nN, gid = wgid / nig, fm = gid * WGM, gsz = (nM - fm) < WGM ? (nM - fm) : WGM;
        u.pm = fm + ((wgid % nig) % gsz); u.pn = (wgid % nig) / gsz; return true;
    }
    __device__ __forceinline__ void a_ready(const Unit&) const {}
    __device__ __forceinline__ void done(const Unit&) const {}
};

__device__ __forceinline__ unsigned cvt_pk_bf16(float lo, float hi) { unsigned r; asm volatile("v_cvt_pk_bf16_f32 %0, %1, %2" : "=v"(r) : "v"(lo), "v"(hi)); return r; }
__device__ __forceinline__ float bf_lo(unsigned w) { return __uint_as_float(w << 16); }
__device__ __forceinline__ float bf_hi(unsigned w) { return __uint_as_float(w & 0xffff0000u); }
__device__ __forceinline__ float fast_sigmoid(float v) { return __builtin_amdgcn_rcpf(1.0f + __builtin_amdgcn_exp2f(-v * 1.4426950408889634f)); }
typedef unsigned u32x2 __attribute__((ext_vector_type(2)));
typedef float f32x2 __attribute__((ext_vector_type(2)));

__device__ __forceinline__ void row_stats(const float* stat, size_t row, int fq, float& rstd, float& nmr) {
    const f32x4* p = (const f32x4*)(stat + row * 32 + 8 * fq);
    const f32x4 a = p[0], b = p[1];
    float s = (a[0] + a[2]) + (b[0] + b[2]), q = (a[1] + a[3]) + (b[1] + b[3]);
    s += __shfl_xor(s, 16); q += __shfl_xor(q, 16); s += __shfl_xor(s, 32); q += __shfl_xor(q, 32);
    const float mean = s * (1.0f / 1024.0f), var = q * (1.0f / 1024.0f) - mean * mean;
    rstd = __builtin_amdgcn_rsqf(var + 1e-5f); nmr = -rstd * mean;
}

constexpr int EPI_TAB = 131072 + 1024, EPI_VEC = EPI_TAB + 8192;
struct PanelSlots { int pm0, pm1, pm2, pm3; __device__ __forceinline__ int slot(int pm) const { return pm == pm0 ? 0 : (pm == pm1 ? 1 : (pm == pm2 ? 2 : 3)); } };
__device__ __forceinline__ PG8_LAS unsigned char* epi_lds(int off) { return (PG8_LAS unsigned char*)(unsigned)off; }
__device__ __forceinline__ void dma_vec(const float* src, PG8_LAS unsigned char* dst) { __builtin_amdgcn_global_load_lds((const unsigned*)src, (PG8_LAS unsigned*)dst, 4, 0, 0); }
template <bool LN> struct EpiIn {
    static constexpr bool PERM = true, AFTER_DRAIN = false;
    bf16_t* QKV; bf16_t* GATES; float qscale; int pm0, pm1, pm2, pm3; const float* cs; const float* bi;
    __device__ __forceinline__ void prefetch(const Unit& u, int wid, int wc, int lane) const {
        const int vo = (u.pm >= 64 ? 5120 : 0) + u.pn * BM + wc * 32 + (lane >> 5) * HALF + (lane & 31);
        dma_vec(cs + vo, epi_lds(EPI_VEC) + wid * 512); dma_vec(bi + vo, epi_lds(EPI_VEC) + wid * 512 + 256);
    }
    __device__ __forceinline__ void init(f32x4 (&acc)[2][2][4][2], const Unit&, int, int, int, int) const {
#pragma unroll
        for (int a = 0; a < 2; ++a)
#pragma unroll
            for (int b = 0; b < 2; ++b)
#pragma unroll
                for (int m = 0; m < 4; ++m)
#pragma unroll
                    for (int n = 0; n < 2; ++n) acc[a][b][m][n] = (f32x4){0.f, 0.f, 0.f, 0.f};
    }
    __device__ __forceinline__ void operator()(const f32x4 (&acc)[2][2][4][2], const Unit& u, int wr, int wc, int fr_, int fq_) const {
        int fr = fr_, fq = fq_; asm volatile("" : "+v"(fr), "+v"(fq));
        const int row0 = u.pm * BM + wr * 64 + fr, cl0 = wc * 32 + 8 * fq;
        const int mode = (u.pn <= 1 || (u.pn >= 3 && u.pn <= 5)) ? 1 : (u.pn >= 12 ? 2 : 0);
        bf16_t* obase; int pitch;
        if (u.pn < 12) { obase = QKV + u.pn * BM + cl0; pitch = 3072; } else { obase = GATES + (u.pn - 12) * BM + cl0; pitch = 2048; }
        f32x4 csv[2][2], biv[2][2]; float rsa[2][4], nma[2][4];
        { const PG8_LAS unsigned char* vb = epi_lds(EPI_VEC) + (wr * 4 + wc) * 512 + 32 * fq;
#pragma unroll
          for (int bj = 0; bj < 2; ++bj)
#pragma unroll
              for (int n = 0; n < 2; ++n) { csv[bj][n] = *(const PG8_LAS f32x4*)(vb + bj * 128 + 16 * n); biv[bj][n] = *(const PG8_LAS f32x4*)(vb + 256 + bj * 128 + 16 * n); }
          const PG8_LAS unsigned char* tb = epi_lds(EPI_TAB) + ((u.pm == pm0 ? 0 : (u.pm == pm1 ? 1 : (u.pm == pm2 ? 2 : 3))) * 256 + wr * 64 + fr) * 8;
#pragma unroll
          for (int ai = 0; ai < 2; ++ai)
#pragma unroll
              for (int m = 0; m < 4; ++m) { rsa[ai][m] = 1.f; nma[ai][m] = 0.f; if (LN) { const f32x2 t = *(const PG8_LAS f32x2*)(tb + (ai * HALF + m * 16) * 8); rsa[ai][m] = t.x; nma[ai][m] = t.y; } } }
#pragma unroll
        for (int ai = 0; ai < 2; ++ai)
#pragma unroll
            for (int m = 0; m < 4; ++m) { const size_t row = (size_t)(row0 + ai * HALF + m * 16); bf16_t* rowp = obase + row * pitch;
                const float rstd = rsa[ai][m], nmr = nma[ai][m];
#pragma unroll
                for (int bj = 0; bj < 2; ++bj) { f32x4 v0 = acc[ai][bj][m][0] * rstd + (csv[bj][0] * nmr + biv[bj][0]), v1 = acc[ai][bj][m][1] * rstd + (csv[bj][1] * nmr + biv[bj][1]);
                    if (mode == 1) { v0 = v0 * qscale; v1 = v1 * qscale; }
                    else if (mode == 2) {
#pragma unroll
                        for (int e = 0; e < 4; ++e) { v0[e] = fast_sigmoid(v0[e]); v1[e] = fast_sigmoid(v1[e]); } }
                    u32x4 w; w.x = cvt_pk_bf16(v0[0], v0[1]); w.y = cvt_pk_bf16(v0[2], v0[3]); w.z = cvt_pk_bf16(v1[0], v1[1]); w.w = cvt_pk_bf16(v1[2], v1[3]);
                    *(u32x4*)(rowp + bj * HALF) = w; } }
    }
};
template <bool ACCUM> struct EpiGate {
    static constexpr bool PERM = true, AFTER_DRAIN = false;
    bf16_t* O; const bf16_t* G; int goff;
    __device__ __forceinline__ void prefetch(const Unit&, int, int, int) const {}
    __device__ __forceinline__ void init(f32x4 (&acc)[2][2][4][2], const Unit&, int, int, int, int) const {
#pragma unroll
        for (int a = 0; a < 2; ++a)
#pragma unroll
            for (int b = 0; b < 2; ++b)
#pragma unroll
                for (int m = 0; m < 4; ++m)
#pragma unroll
                    for (int n = 0; n < 2; ++n) acc[a][b][m][n] = (f32x4){0.f, 0.f, 0.f, 0.f};
    }
    __device__ __forceinline__ void operator()(const f32x4 (&acc)[2][2][4][2], const Unit& u, int wr, int wc, int fr_, int fq_) const {
        int fr = fr_, fq = fq_; asm volatile("" : "+v"(fr), "+v"(fq));
        const int row0 = u.pm * BM + wr * 64 + fr, col0 = u.pn * BM + wc * 32 + 8 * fq;
#pragma unroll
        for (int ai = 0; ai < 2; ++ai) {
            u32x4 gq[4][2], pq[4][2];
#pragma unroll
            for (int m = 0; m < 4; ++m)
#pragma unroll
                for (int bj = 0; bj < 2; ++bj) { const size_t row = (size_t)(row0 + ai * HALF + m * 16);
                    gq[m][bj] = *(const u32x4*)(G + row * 2048 + goff + col0 + bj * HALF);
                    if (ACCUM) pq[m][bj] = *(const u32x4*)(O + row * 1024 + col0 + bj * HALF); }
#pragma unroll
            for (int m = 0; m < 4; ++m) { const size_t row = (size_t)(row0 + ai * HALF + m * 16); bf16_t* rowp = O + row * 1024 + col0;
#pragma unroll
                for (int bj = 0; bj < 2; ++bj) { const f32x4 v0 = acc[ai][bj][m][0], v1 = acc[ai][bj][m][1];
                    const u32x4 g = gq[m][bj];
                    float o[8];
                    o[0] = bf_lo(g.x) * v0[0]; o[1] = bf_hi(g.x) * v0[1]; o[2] = bf_lo(g.y) * v0[2]; o[3] = bf_hi(g.y) * v0[3];
                    o[4] = bf_lo(g.z) * v1[0]; o[5] = bf_hi(g.z) * v1[1]; o[6] = bf_lo(g.w) * v1[2]; o[7] = bf_hi(g.w) * v1[3];
                    if (ACCUM) { const u32x4 p = pq[m][bj];
                        o[0] += bf_lo(p.x); o[1] += bf_hi(p.x); o[2] += bf_lo(p.y); o[3] += bf_hi(p.y); o[4] += bf_lo(p.z); o[5] += bf_hi(p.z); o[6] += bf_lo(p.w); o[7] += bf_hi(p.w); }
                    u32x4 w; w.x = cvt_pk_bf16(o[0], o[1]); w.y = cvt_pk_bf16(o[2], o[3]); w.z = cvt_pk_bf16(o[4], o[5]); w.w = cvt_pk_bf16(o[6], o[7]);
                    *(u32x4*)(rowp + bj * HALF) = w; } }
            asm volatile("" ::: "memory"); }
    }
};
template <bool LN> struct EpiRes {
    static constexpr bool PERM = true, AFTER_DRAIN = false;
    const float* xin; bf16_t* zh; const float* stat_in; float* stat_out; const float* gamma; const float* beta; float alpha;
    __device__ __forceinline__ void prefetch(const Unit&, int, int, int) const {}
    __device__ __forceinline__ void init(f32x4 (&acc)[2][2][4][2], const Unit& u, int wr, int wc, int fr_, int fq_) const {
        int fr = fr_, fq = fq_; asm volatile("" : "+v"(fr), "+v"(fq));
        const int row0 = u.pm * BM + wr * 64 + fr, col0 = u.pn * BM + wc * 32 + 8 * fq;
        float rs[2][4], nm[2][4];
#pragma unroll
        for (int ai = 0; ai < 2; ++ai) {
#pragma unroll
            for (int m = 0; m < 4; ++m) { rs[ai][m] = alpha; nm[ai][m] = 0.f; if (LN) row_stats(stat_in, (size_t)(row0 + ai * HALF + m * 16), fq, rs[ai][m], nm[ai][m]); }
            asm volatile("" ::: "memory"); }
#pragma unroll
        for (int bj = 0; bj < 2; ++bj) { const int c = col0 + bj * HALF;
            f32x4 ga0 = {1.f, 1.f, 1.f, 1.f}, ga1 = ga0, be0 = {0.f, 0.f, 0.f, 0.f}, be1 = be0;
            if (LN) { ga0 = *(const f32x4*)(gamma + c) * alpha; ga1 = *(const f32x4*)(gamma + c + 4) * alpha; be0 = *(const f32x4*)(beta + c) * alpha; be1 = *(const f32x4*)(beta + c + 4) * alpha; }
#pragma unroll
            for (int ai = 0; ai < 2; ++ai)
#pragma unroll
                for (int m = 0; m < 4; ++m) { const size_t off = (size_t)(row0 + ai * HALF + m * 16) * 1024 + c;
                    if (LN) { const u32x4 h = *(const u32x4*)(zh + off);
                        const f32x4 z0 = {h_lo(h.x), h_hi(h.x), h_lo(h.y), h_hi(h.y)}, z1 = {h_lo(h.z), h_hi(h.z), h_lo(h.w), h_hi(h.w)};
                        acc[ai][bj][m][0] = (z0 * rs[ai][m] + nm[ai][m]) * ga0 + be0; acc[ai][bj][m][1] = (z1 * rs[ai][m] + nm[ai][m]) * ga1 + be1; }
                    else { acc[ai][bj][m][0] = __builtin_nontemporal_load((const f32x4*)(xin + off)) * rs[ai][m]; acc[ai][bj][m][1] = __builtin_nontemporal_load((const f32x4*)(xin + off + 4)) * rs[ai][m]; } } }
    }
    __device__ __forceinline__ void operator()(const f32x4 (&acc)[2][2][4][2], const Unit& u, int wr, int wc, int fr_, int fq_) const {
        int fr = fr_, fq = fq_; asm volatile("" : "+v"(fr), "+v"(fq));
        const int row0 = u.pm * BM + wr * 64 + fr, col0 = u.pn * BM + wc * 32 + 8 * fq;
#pragma unroll
        for (int ai = 0; ai < 2; ++ai)
#pragma unroll
            for (int m = 0; m < 4; ++m) { const size_t rowo = (size_t)(row0 + ai * HALF + m * 16); float s = 0.f, q = 0.f;
#pragma unroll
                for (int bj = 0; bj < 2; ++bj) { const size_t off = rowo * 1024 + col0 + bj * HALF; const f32x4 z0 = acc[ai][bj][m][0], z1 = acc[ai][bj][m][1];
                    u32x4 w; w.x = pk_f16(z0[0], z0[1]); w.y = pk_f16(z0[2], z0[3]); w.z = pk_f16(z1[0], z1[1]); w.w = pk_f16(z1[2], z1[3]); *(u32x4*)(zh + off) = w;
                    s += ((z0[0] + z0[1]) + (z0[2] + z0[3])) + ((z1[0] + z1[1]) + (z1[2] + z1[3]));
                    q += ((z0[0] * z0[0] + z0[1] * z0[1]) + (z0[2] * z0[2] + z0[3] * z0[3])) + ((z1[0] * z1[0] + z1[1] * z1[1]) + (z1[2] * z1[2] + z1[3] * z1[3])); }
                s += __shfl_xor(s, 16); q += __shfl_xor(q, 16); s += __shfl_xor(s, 32); q += __shfl_xor(q, 32);
                if (fq == 0) { f32x2 o = {s, q}; *(f32x2*)(stat_out + (rowo * 16 + u.pn * 4 + wc) * 2) = o; } }
    }
};
struct EpiSwiGLU {
    static constexpr bool PERM = true, AFTER_DRAIN = false;
    bf16_t* O; int pm0, pm1, pm2, pm3; const float* cs; const float* bi;
    __device__ __forceinline__ void prefetch(const Unit& u, int wid, int wc, int lane) const {
        const int vo = (u.pm >= 64 ? 5632 : 0) + u.pn * BM + wc * 32 + (lane >> 5) * HALF + (lane & 31);
        dma_vec(cs + vo, epi_lds(EPI_VEC) + wid * 512); dma_vec(bi + vo, epi_lds(EPI_VEC) + wid * 512 + 256);
    }
    __device__ __forceinline__ void init(f32x4 (&acc)[2][2][4][2], const Unit&, int, int, int, int) const {
#pragma unroll
        for (int a = 0; a < 2; ++a)
#pragma unroll
            for (int b = 0; b < 2; ++b)
#pragma unroll
                for (int m = 0; m < 4; ++m)
#pragma unroll
                    for (int n = 0; n < 2; ++n) acc[a][b][m][n] = (f32x4){0.f, 0.f, 0.f, 0.f};
    }
    __device__ __forceinline__ void operator()(const f32x4 (&acc)[2][2][4][2], const Unit& u, int wr, int wc, int fr_, int fq_) const {
        int fr = fr_, fq = fq_; asm volatile("" : "+v"(fr), "+v"(fq));
        const int row0 = u.pm * BM + wr * 64 + fr, col0 = u.pn * HALF + wc * 32 + 8 * fq;
        f32x4 csv[2][2], biv[2][2]; float rsa[2][4], nma[2][4];
        { const PG8_LAS unsigned char* vb = epi_lds(EPI_VEC) + (wr * 4 + wc) * 512 + 32 * fq;
#pragma unroll
          for (int bj = 0; bj < 2; ++bj)
#pragma unroll
              for (int n = 0; n < 2; ++n) { csv[bj][n] = *(const PG8_LAS f32x4*)(vb + bj * 128 + 16 * n); biv[bj][n] = *(const PG8_LAS f32x4*)(vb + 256 + bj * 128 + 16 * n); }
          const PG8_LAS unsigned char* tb = epi_lds(EPI_TAB) + ((u.pm == pm0 ? 0 : (u.pm == pm1 ? 1 : (u.pm == pm2 ? 2 : 3))) * 256 + wr * 64 + fr) * 8;
#pragma unroll
          for (int ai = 0; ai < 2; ++ai)
#pragma unroll
              for (int m = 0; m < 4; ++m) { const f32x2 t = *(const PG8_LAS f32x2*)(tb + (ai * HALF + m * 16) * 8); rsa[ai][m] = t.x; nma[ai][m] = t.y; } }
#pragma unroll
        for (int ai = 0; ai < 2; ++ai) {
#pragma unroll
            for (int m = 0; m < 4; ++m) { const size_t row = (size_t)(row0 + ai * HALF + m * 16); bf16_t* rowp = O + row * 2816 + col0;
                const float rstd = rsa[ai][m], nmr = nma[ai][m];
                float o[8];
#pragma unroll
                for (int n = 0; n < 2; ++n) { const f32x4 gt = acc[ai][0][m][n] * rstd + (csv[0][n] * nmr + biv[0][n]), up = acc[ai][1][m][n] * rstd + (csv[1][n] * nmr + biv[1][n]);
#pragma unroll
                    for (int e = 0; e < 4; ++e) o[4 * n + e] = gt[e] * fast_sigmoid(gt[e]) * up[e]; }
                u32x4 w; w.x = cvt_pk_bf16(o[0], o[1]); w.y = cvt_pk_bf16(o[2], o[3]); w.z = cvt_pk_bf16(o[4], o[5]); w.w = cvt_pk_bf16(o[6], o[7]);
                *(u32x4*)(rowp) = w; } }
    }
};

template <class Epi, class Sched, bool ALIGN_EPI = false, bool SP2 = false, bool F16 = false>
__device__ __forceinline__ void gemm_phase(PG8_LAS unsigned char* lds, const Gemm g, const Sched& S, const Epi& E) {
    int tid_ = threadIdx.x; asm volatile("" : "+v"(tid_)); const int tid = tid_, wid = __builtin_amdgcn_readfirstlane(tid >> 6), lane = tid & 63, wr = wid >> 2, wc = wid & 3, fr = lane & 15, fq = lane >> 4;
    const int K = g.K, nt = K / BK;
    unsigned voffA[2], voffB[2];
#pragma unroll
    for (int i = 0; i < 2; ++i) { int R, C; stage_rc(tid * 16 + i * 8192, R, C); const int Rb = Epi::PERM ? ((R & ~31) + perm32(R & 31)) : R;
        voffA[i] = (unsigned)(R * K + C) * 2u; voffB[i] = (unsigned)(Rb * K + C) * 2u; }
    const size_t kstep = (size_t)(BK * 2);
    const size_t hstep = (size_t)HALF * K * 2;
    const size_t tstep = 2 * hstep;
    const unsigned ldsw = (unsigned)wid * 1024u;
    const int aoff = lds_byte(wr * 64 + fr, fq * 8), boff = lds_byte(wc * 32 + fr, fq * 8);
#define PG8_SA(b, h) (((b) * 2 + (h)) * HTB)
#define PG8_SB(b, h) ((4 + (b) * 2 + (h)) * HTB)
#define PG8_STAGE(bufoff, gbase, voff) do { _Pragma("unroll") for (int _i = 0; _i < 2; ++_i) \
        __builtin_amdgcn_global_load_lds((const unsigned*)((const char*)(gbase) + (voff)[_i]), (PG8_LAS unsigned*)(lds + (bufoff) + ldsw + _i * 8192), 16, 0, 0); } while (0)
#define PG8_LDA(dst, b, h) do { _Pragma("unroll") for (int m = 0; m < 4; ++m) _Pragma("unroll") for (int k = 0; k < 2; ++k) dst[m][k] = *(const PG8_LAS bf16x8*)(lds + PG8_SA(b, h) + aoff + m * 2048 + k * 1024); } while (0)
#define PG8_LDB(dst, b, h) do { _Pragma("unroll") for (int n = 0; n < 2; ++n) _Pragma("unroll") for (int k = 0; k < 2; ++k) dst[n][k] = *(const PG8_LAS bf16x8*)(lds + PG8_SB(b, h) + boff + n * 2048 + k * 1024); } while (0)
#define PG8_MMA(ai, bj, At, Bt) do { __builtin_amdgcn_s_setprio(1); _Pragma("unroll") for (int m = 0; m < 4; ++m) _Pragma("unroll") for (int n = 0; n < 2; ++n) _Pragma("unroll") for (int k = 0; k < 2; ++k) \
        acc[ai][bj][m][n] = mma16<F16>(Bt[n][k], At[m][k], acc[ai][bj][m][n]); __builtin_amdgcn_s_setprio(0); } while (0)
#define PG8_WAIT_V(n) asm volatile("s_waitcnt vmcnt(" #n ")" ::: "memory")
#define PG8_WAIT_L(n) asm volatile("s_waitcnt lgkmcnt(" #n ")" ::: "memory")
#define PG8_BAR __builtin_amdgcn_s_barrier()
#define PG8_SCHED __builtin_amdgcn_sched_barrier(0)
    Unit cur, nxt; int ui = 0;
    if (!S.next(0, cur)) return;
    f32x4 acc[2][2][4][2];
    E.init(acc, cur, wr, wc, fr, fq);
    bf16x8 At[4][2], B0[2][2], B1[2][2];
    const char* cA = (const char*)g.A + (size_t)cur.pm * tstep; const char* cB = (const char*)(cur.pm >= g.mb ? g.Bt1 : g.Bt) + (size_t)cur.pn * tstep;
    S.a_ready(cur);
    if constexpr (SP2) {
        PG8_STAGE(PG8_SB(0, 0), cB, voffB); PG8_STAGE(PG8_SB(0, 1), cB + hstep, voffB); PG8_STAGE(PG8_SA(0, 0), cA, voffA); PG8_STAGE(PG8_SA(0, 1), cA + hstep, voffA);
        if (wr == 1) PG8_BAR;
        PG8_WAIT_V(2); PG8_BAR;
        PG8_STAGE(PG8_SB(1, 0), cB + kstep, voffB); PG8_STAGE(PG8_SA(1, 0), cA + kstep, voffA); PG8_STAGE(PG8_SB(1, 1), cB + hstep + kstep, voffB);
        PG8_WAIT_V(6); PG8_BAR;
    } else {
        PG8_STAGE(PG8_SB(0, 0), cB, voffB); PG8_STAGE(PG8_SA(0, 0), cA, voffA); PG8_STAGE(PG8_SB(0, 1), cB + hstep, voffB); PG8_STAGE(PG8_SA(0, 1), cA + hstep, voffA);
        if (wr == 1) PG8_BAR;
        PG8_WAIT_V(4); PG8_BAR;
        PG8_STAGE(PG8_SB(1, 0), cB + kstep, voffB); PG8_STAGE(PG8_SA(1, 0), cA + kstep, voffA); PG8_STAGE(PG8_SB(1, 1), cB + hstep + kstep, voffB);
        PG8_WAIT_V(6); PG8_BAR;
    }
    for (;;) {
        const bool has_next = S.next(ui + 1, nxt);
        const char* nA = has_next ? (const char*)g.A + (size_t)nxt.pm * tstep : cA; const char* nB = has_next ? (const char*)(nxt.pm >= g.mb ? g.Bt1 : g.Bt) + (size_t)nxt.pn * tstep : cB;
        for (int t = 0; t < nt; t += 2) {
            const bool last = (t == nt - 2);
            const char* a1 = cA + (size_t)(t + 1) * kstep;
            const char* a2 = last ? nA : cA + (size_t)(t + 2) * kstep; const char* b2 = last ? nB : cB + (size_t)(t + 2) * kstep;
            const char* a3 = a2 + kstep; const char* b3 = b2 + kstep;
            if (last && has_next) S.a_ready(nxt);
            if (last) E.prefetch(cur, wid, wc, lane);
            if constexpr (SP2) {
            PG8_LDB(B0, 0, 0); PG8_LDB(B1, 0, 1); PG8_SCHED; PG8_LDA(At, 0, 0); PG8_STAGE(PG8_SA(1, 1), a1 + hstep, voffA);
            PG8_WAIT_V(8); PG8_WAIT_L(0); PG8_BAR; PG8_MMA(0, 0, At, B0); PG8_MMA(0, 1, At, B1); PG8_BAR; PG8_SCHED;
            PG8_LDA(At, 0, 1); PG8_STAGE(PG8_SB(0, 0), b2, voffB); PG8_STAGE(PG8_SB(0, 1), b2 + hstep, voffB); PG8_STAGE(PG8_SA(0, 0), a2, voffA);
            PG8_WAIT_V(8); PG8_WAIT_L(0); PG8_BAR; PG8_MMA(1, 0, At, B0); PG8_MMA(1, 1, At, B1); PG8_BAR; PG8_SCHED;
            PG8_LDB(B0, 1, 0); PG8_LDB(B1, 1, 1); PG8_SCHED; PG8_LDA(At, 1, 0); PG8_STAGE(PG8_SA(0, 1), a2 + hstep, voffA);
            PG8_WAIT_V(8); PG8_WAIT_L(0); PG8_BAR; PG8_MMA(0, 0, At, B0); PG8_MMA(0, 1, At, B1); PG8_BAR; PG8_SCHED;
            PG8_LDA(At, 1, 1); PG8_STAGE(PG8_SB(1, 0), b3, voffB); PG8_STAGE(PG8_SB(1, 1), b3 + hstep, voffB); PG8_STAGE(PG8_SA(1, 0), a3, voffA);
            PG8_WAIT_V(8); PG8_WAIT_L(0); PG8_BAR; PG8_MMA(1, 0, At, B0); PG8_MMA(1, 1, At, B1); PG8_BAR; PG8_SCHED;
            } else {
            PG8_LDB(B0, 0, 0); PG8_SCHED; PG8_LDA(At, 0, 0); PG8_STAGE(PG8_SA(1, 1), a1 + hstep, voffA);
            PG8_WAIT_L(8); PG8_BAR; PG8_WAIT_L(0); PG8_MMA(0, 0, At, B0); PG8_BAR; PG8_SCHED;
            PG8_LDB(B1, 0, 1); PG8_STAGE(PG8_SB(0, 0), b2, voffB);
            PG8_BAR; PG8_WAIT_L(0); PG8_MMA(0, 1, At, B1); PG8_BAR;
            PG8_LDA(At, 0, 1); PG8_STAGE(PG8_SA(0, 0), a2, voffA);
            PG8_BAR; PG8_WAIT_L(0); PG8_MMA(1, 0, At, B0); PG8_BAR; PG8_SCHED;
            PG8_STAGE(PG8_SB(0, 1), b2 + hstep, voffB);
            PG8_WAIT_V(6); PG8_BAR; PG8_MMA(1, 1, At, B1); PG8_BAR;
            PG8_LDB(B0, 1, 0); PG8_SCHED; PG8_LDA(At, 1, 0); PG8_STAGE(PG8_SA(0, 1), a2 + hstep, voffA);
            PG8_WAIT_L(8); PG8_BAR; PG8_WAIT_L(0); PG8_MMA(0, 0, At, B0); PG8_BAR; PG8_SCHED;
            PG8_LDB(B1, 1, 1); PG8_STAGE(PG8_SB(1, 0), b3, voffB);
            PG8_BAR; PG8_WAIT_L(0); PG8_MMA(0, 1, At, B1); PG8_BAR;
            PG8_LDA(At, 1, 1); PG8_STAGE(PG8_SA(1, 0), a3, voffA);
            PG8_BAR; PG8_WAIT_L(0); PG8_MMA(1, 0, At, B0); PG8_BAR; PG8_SCHED;
            PG8_STAGE(PG8_SB(1, 1), b3 + hstep, voffB);
            PG8_WAIT_V(6); PG8_BAR; PG8_MMA(1, 1, At, B1); PG8_BAR;
            }
        }
        if constexpr (ALIGN_EPI) { if (wr == 0) PG8_BAR; }
        if constexpr (!Epi::AFTER_DRAIN) { E(acc, cur, wr, wc, fr, fq); S.done(cur); }
        if (!has_next) break;
        E.init(acc, nxt, wr, wc, fr, fq);
        cur = nxt; cA = nA; cB = nB; ++ui;
        if constexpr (ALIGN_EPI) { if (wr == 1) PG8_BAR; }
    }
    PG8_WAIT_V(0);
    if constexpr (!ALIGN_EPI) { if (wr == 0) PG8_BAR; }
    PG8_BAR;
    if constexpr (Epi::AFTER_DRAIN) { E.fused(acc, cur, wr, wc, fr, fq, lds, wid, lane); S.done(cur); }
#undef PG8_SA
#undef PG8_SB
#undef PG8_STAGE
#undef PG8_LDA
#undef PG8_LDB
#undef PG8_MMA
#undef PG8_WAIT_V
#undef PG8_WAIT_L
#undef PG8_BAR
#undef PG8_SCHED
}
}

#define LAS __attribute__((address_space(3)))
typedef unsigned short bf16;
typedef unsigned v4u __attribute__((ext_vector_type(4)));
typedef unsigned v2u __attribute__((ext_vector_type(2)));
typedef float f32x4 __attribute__((ext_vector_type(4)));
typedef float f32x16 __attribute__((ext_vector_type(16)));
typedef short bf16x8 __attribute__((ext_vector_type(8)));
typedef short v4i16_t __attribute__((ext_vector_type(4)));
using pg8::cvt_pk_bf16; using pg8::bf_lo; using pg8::bf_hi; using pg8::pk_f16; using pg8::h_lo; using pg8::h_hi;

#define XB_TMO      128
#define XB_XCNT(j)  (256  + 64 * (j))
#define XB_XSUB(j)  (1280 + 64 * (j))
#define XB_XGEN(j)  (2304 + 64 * (j))
#define XB_TOP      3328
#define XB_TOPGEN   3392
#define XCD_BAR_WORDS 3456
#define XB_SPIN_CAP (1u << 18)

__device__ __forceinline__ unsigned xb_ld(unsigned* p)              { return __hip_atomic_load(p, __ATOMIC_RELAXED, __HIP_MEMORY_SCOPE_AGENT); }
__device__ __forceinline__ unsigned xb_add(unsigned* p, unsigned v) { return __hip_atomic_fetch_add(p, v, __ATOMIC_RELAXED, __HIP_MEMORY_SCOPE_AGENT); }
__device__ __forceinline__ unsigned xb_xcc_id() { return (unsigned)__builtin_amdgcn_s_getreg((3 << 11) | 20) & 0xFu; }
#define XB_SPIN(cond, bar) do { unsigned _sp = 0; while (cond) { __builtin_amdgcn_s_sleep(1); \
    if ((++_sp & 255u) == 0u) { if (xb_ld(&(bar)[XB_TMO])) break; if (_sp > XB_SPIN_CAP) { atomicAdd(&(bar)[XB_TMO], 1u); break; } } } } while (0)

struct XcdBarrier {
    unsigned* bar; unsigned x;
    volatile LAS unsigned* st;
};

__device__ __forceinline__ XcdBarrier xcd_barrier_post(unsigned* bar, volatile LAS unsigned* st) {
    XcdBarrier b; b.bar = bar; b.x = xb_xcc_id(); b.st = st;
    if (threadIdx.x == 0) (void)xb_add(&bar[XB_XCNT(b.x)], 1u);
    return b;
}
__device__ __forceinline__ void xcd_barrier_complete(unsigned* bar, unsigned x, unsigned& nloc, unsigned& nx) {
    const unsigned G = gridDim.x * gridDim.y * gridDim.z;
    unsigned sum, cnt, mine, sp = 0u;
    for (;;) {
        sum = 0u; cnt = 0u; mine = 0u;
#pragma unroll
        for (unsigned j = 0; j < 16; ++j) { const unsigned c = xb_ld(&bar[XB_XCNT(j)]); sum += c; cnt += (c > 0u) ? 1u : 0u; mine = (j == x) ? c : mine; }
        if (sum == G) break;
        __builtin_amdgcn_s_sleep(1);
        if ((++sp & 255u) == 0u) { if (xb_ld(&bar[XB_TMO])) break; if (sp > XB_SPIN_CAP) { atomicAdd(&bar[XB_TMO], 1u); break; } }
    }
    nloc = mine > 0u ? mine : 1u; nx = cnt > 0u ? cnt : 1u;
}

__device__ __forceinline__ void xcd_barrier(const XcdBarrier& b) {
    asm volatile("s_waitcnt vmcnt(0)" ::: "memory");
    __syncthreads();
    if (threadIdx.x == 0) {
        unsigned* bar = b.bar;
        __builtin_amdgcn_s_waitcnt(0);
        unsigned nloc = b.st[0], nx = b.st[1];
        if (nloc == 0u) { xcd_barrier_complete(bar, b.x, nloc, nx); b.st[0] = nloc; b.st[1] = nx; }
        const unsigned old = xb_add(&bar[XB_XSUB(b.x)], 1u);
        const unsigned gen = old / nloc;
        if (old + 1u == (gen + 1u) * nloc) {
            __builtin_amdgcn_fence(__ATOMIC_RELEASE, "agent");
            asm volatile("s_waitcnt vmcnt(0)" ::: "memory");
            const unsigned og = xb_add(&bar[XB_TOP], 1u);
            const unsigned tg = og / nx;
            if (og + 1u == (tg + 1u) * nx) xb_add(&bar[XB_TOPGEN], 1u);
            else XB_SPIN(xb_ld(&bar[XB_TOPGEN]) == tg, bar);
            __builtin_amdgcn_fence(__ATOMIC_ACQUIRE, "agent");
            xb_add(&bar[XB_XGEN(b.x)], 1u);
            asm volatile("s_waitcnt vmcnt(0)" ::: "memory");
        } else {
            XB_SPIN(xb_ld(&bar[XB_XGEN(b.x)]) == gen, bar);
            __builtin_amdgcn_fence(__ATOMIC_ACQUIRE, "agent");
            asm volatile("s_waitcnt vmcnt(0)" ::: "memory");
        }
    }
    __syncthreads();
}


constexpr int NWAVES = 8, NTHREADS = 512;
constexpr int LDS_BYTES = 147456;
constexpr int MISC_OFF = 131072 + 320;
constexpr size_t MiB = 1u << 20;
constexpr size_t WS_MOD = 0;
constexpr size_t WS_BAR = 512 * 1024;
constexpr size_t WS_LSE = 1 * MiB;
constexpr size_t WS_W = 3 * MiB;
constexpr size_t W_IN = 0, W_IN1 = 10 * MiB, W_A = 20 * MiB, W_B = 21 * MiB, W_O = 22 * MiB, W_GU = 24 * MiB, W_GU1 = 35 * MiB, W_D = 46 * MiB;
constexpr size_t WS_VEC = 55 * MiB;
constexpr int VEC_LAYER = 2 * 2 * 5120 + 2 * 2 * 5632, V_CS_IN = 0, V_BI_IN = 2 * 5120, V_CS_GU = 4 * 5120, V_BI_GU = 4 * 5120 + 2 * 5632;
constexpr size_t WS_STAT1 = 56 * MiB, WS_STAT2 = 60 * MiB;
constexpr size_t WS_ZB = 64 * MiB;
constexpr size_t WS_YA = 128 * MiB;
constexpr size_t WS_YB = 160 * MiB;
constexpr size_t WS_QKV = 176 * MiB;
constexpr size_t WS_ZLO = 368 * MiB;
constexpr size_t WS_OG = 432 * MiB;
constexpr size_t WS_W2 = 496 * MiB;
constexpr size_t W2_O1 = 0, W2_D1 = 2 * MiB;
constexpr size_t WS_END = 504 * MiB;
constexpr int QKVW = 3072;

struct Params {
    const float *x, *c, *w_ada, *b_ada, *w_in, *sinks, *w_a, *w_b, *w_o, *ln1_g, *ln1_b, *w_gate, *w_up, *w_down, *ln2_g, *ln2_b;
    float* out; unsigned char* ws;
};

__device__ __forceinline__ int opaque_tid() { int t = threadIdx.x; asm volatile("" : "+v"(t)); return t; }
__device__ __forceinline__ float wave_sum(float v) {
#pragma unroll
    for (int o = 1; o < 64; o <<= 1) v += __shfl_xor(v, o);
    return v;
}

__device__ __forceinline__ void phase_mods(const Params& P, unsigned char* lds) {
    float* red = (float*)lds;
    float* mod = (float*)(P.ws + WS_MOD);
    const int tid = opaque_tid(), kg = tid >> 4, cl = tid & 15;
    for (int item = blockIdx.x; item < DEPTH * 96; item += gridDim.x) {
        const int l = item / 96, j0 = (item % 96) * 64;
        const float* w = P.w_ada + (size_t)l * DM * 6 * DM + j0 + 4 * cl;
        f32x4 a0 = {0.f, 0.f, 0.f, 0.f}, a1 = {0.f, 0.f, 0.f, 0.f};
#pragma unroll 8
        for (int kk = 0; kk < 32; ++kk) { const int k = kg * 32 + kk;
            const f32x4 wv = *(const f32x4*)(w + (size_t)k * 6 * DM);
            const float c0 = P.c[k], c1 = P.c[DM + k];
            const float s0 = c0 / (1.f + __expf(-c0)), s1 = c1 / (1.f + __expf(-c1));
            a0 += wv * s0; a1 += wv * s1; }
        float* rp = red + (kg * 16 + cl) * 8;
        rp[0] = a0[0]; rp[1] = a0[1]; rp[2] = a0[2]; rp[3] = a0[3]; rp[4] = a1[0]; rp[5] = a1[1]; rp[6] = a1[2]; rp[7] = a1[3];
        __syncthreads();
        if (tid < 128) { const int c2 = tid >> 3, i = tid & 7; float s = 0.f;
#pragma unroll 8
            for (int g = 0; g < 32; ++g) s += red[(g * 16 + c2) * 8 + i];
            const int b = i >> 2, col = j0 + 4 * c2 + (i & 3);
            mod[(size_t)(l * 2 + b) * 6 * DM + col] = s + P.b_ada[(size_t)l * 6 * DM + col]; }
        __syncthreads();
    }
}

struct Fold { const float* g; const float* b; const float* m0; const float* m1; int sc, sh; };
__device__ __forceinline__ float bf_round(float f) { unsigned u = __builtin_bit_cast(unsigned, f); u = (u + 0x7fffu + ((u >> 16) & 1u)) & 0xffff0000u; return __uint_as_float(u); }

__device__ __forceinline__ void phase_vecs(const Params& P, unsigned char* lds) {
    float* red = (float*)lds;
    const float* mod = (const float*)(P.ws + WS_MOD);
    float* vec = (float*)(P.ws + WS_VEC);
    const int tid = opaque_tid(), kg = tid >> 4, cl = tid & 15;
    for (int item = blockIdx.x; item < DEPTH * 168; item += gridDim.x) {
        const int l = item / 168, r = item % 168;
        const float* W; int N, j0, mat; Fold F; F.m0 = mod + (size_t)l * 12 * DM; F.m1 = F.m0 + 6 * DM;
        if (r < 80) { mat = 0; W = P.w_in + (size_t)l * DM * INW; N = INW; j0 = r * 64; F.g = l ? P.ln2_g + (l - 1) * DM : nullptr; F.b = l ? P.ln2_b + (l - 1) * DM : nullptr; F.sc = 1 * DM; F.sh = 0; }
        else { mat = 1 + (r - 80) / 44; W = (mat == 1 ? P.w_gate : P.w_up) + (size_t)l * DM * DFF; N = DFF; j0 = ((r - 80) % 44) * 64; F.g = P.ln1_g + l * DM; F.b = P.ln1_b + l * DM; F.sc = 4 * DM; F.sh = 3 * DM; }
        const float* w = W + j0 + 4 * cl;
        f32x4 a0 = {0.f, 0.f, 0.f, 0.f}, a1 = a0, a2 = a0, a3 = a0;
#pragma unroll 4
        for (int kk = 0; kk < 32; ++kk) { const int k = kg * 32 + kk;
            const f32x4 wv = *(const f32x4*)(w + (size_t)k * N);
            const float gp = F.g ? F.g[k] : 1.f, bp = F.b ? F.b[k] : 0.f;
            const float s0 = 1.f + F.m0[F.sc + k], s1 = 1.f + F.m1[F.sc + k];
            const float g0 = gp * s0, g1 = gp * s1, b0 = bp * s0 + F.m0[F.sh + k], b1 = bp * s1 + F.m1[F.sh + k];
#pragma unroll
            for (int e = 0; e < 4; ++e) { a0[e] += (float)(_Float16)(g0 * wv[e]); a1[e] += (float)(_Float16)(g1 * wv[e]); }
            a2 += wv * b0; a3 += wv * b1; }
        float* rp = red + (kg * 16 + cl) * 16;
        *(f32x4*)(rp) = a0; *(f32x4*)(rp + 4) = a1; *(f32x4*)(rp + 8) = a2; *(f32x4*)(rp + 12) = a3;
        __syncthreads();
        if (tid < 256) { const int c2 = tid >> 4, i = tid & 15; float s = 0.f;
#pragma unroll 8
            for (int g = 0; g < 32; ++g) s += red[(g * 16 + c2) * 16 + i];
            const int which = i >> 2, col = j0 + 4 * c2 + (i & 3), b = which & 1;
            float* vl = vec + (size_t)l * VEC_LAYER;
            if (mat == 0) vl[(which < 2 ? V_CS_IN : V_BI_IN) + b * 5120 + col] = s;
            else { const int tr = (col >> 7) * 256 + (col & 127) + (mat == 2 ? 128 : 0); vl[(which < 2 ? V_CS_GU : V_BI_GU) + b * 5632 + tr] = s; } }
        __syncthreads();
    }
}

__device__ __forceinline__ unsigned f2bf(float f) { unsigned u = __builtin_bit_cast(unsigned, f); return (u + 0x7fffu + ((u >> 16) & 1u)) >> 16; }
__device__ __forceinline__ unsigned pk2(float lo, float hi) { return f2bf(lo) | (f2bf(hi) << 16); }
template <int FOLD>
__device__ __forceinline__ void transpose_item(const float* W, int K, int N, bf16* WT0, bf16* WT1, const Fold& F, int mode, float* scr, int item, int lane) {
    const int nblk = N / 32, kb = item / nblk, nb = item % nblk, k0 = 64 * kb, n0 = 32 * nb;
    const int drow0 = (mode == 0) ? n0 : ((n0 >> 7) * 256 + (n0 & 127) + (mode == 2 ? 128 : 0));
#pragma unroll 8
    for (int i = 0; i < 32; ++i) { const int kk = 2 * i + (lane >> 5); scr[kk * 33 + (lane & 31)] = W[(size_t)(k0 + kk) * N + n0 + (lane & 31)]; }
    const int c = lane & 7;
    float g0[8], g1[8];
    if (FOLD == 1) {
#pragma unroll
        for (int i = 0; i < 8; ++i) { const int k = k0 + 8 * c + i; const float gp = F.g ? F.g[k] : 1.f; g0[i] = gp * (1.f + F.m0[F.sc + k]); g1[i] = gp * (1.f + F.m1[F.sc + k]); } }
    float h0[4], h1[4];
    if (FOLD == 2) {
#pragma unroll
        for (int j = 0; j < 4; ++j) { const int n = n0 + (lane >> 3) + 8 * j; h0[j] = F.m0[F.sc + n]; h1[j] = F.m1[F.sc + n]; } }
    asm volatile("s_waitcnt lgkmcnt(0)" ::: "memory");
#pragma unroll
    for (int j = 0; j < 4; ++j) { const int n = (lane >> 3) + 8 * j; const float* s = scr + (8 * c) * 33 + n;
        float v[8];
#pragma unroll
        for (int i = 0; i < 8; ++i) v[i] = s[i * 33];
        if (FOLD == 2) {
#pragma unroll
            for (int i = 0; i < 8; ++i) { g0[i] = h0[j]; g1[i] = h1[j]; } }
        if (FOLD == 1) {
            v4u o; o.x = pk_f16(v[0] * g0[0], v[1] * g0[1]); o.y = pk_f16(v[2] * g0[2], v[3] * g0[3]); o.z = pk_f16(v[4] * g0[4], v[5] * g0[5]); o.w = pk_f16(v[6] * g0[6], v[7] * g0[7]);
            *(v4u*)(WT0 + (size_t)(drow0 + n) * K + k0 + 8 * c) = o;
            v4u p; p.x = pk_f16(v[0] * g1[0], v[1] * g1[1]); p.y = pk_f16(v[2] * g1[2], v[3] * g1[3]); p.z = pk_f16(v[4] * g1[4], v[5] * g1[5]); p.w = pk_f16(v[6] * g1[6], v[7] * g1[7]);
            *(v4u*)(WT1 + (size_t)(drow0 + n) * K + k0 + 8 * c) = p;
        } else if (FOLD == 2) {
            v4u o; o.x = pk2(v[0] * g0[0], v[1] * g0[1]); o.y = pk2(v[2] * g0[2], v[3] * g0[3]); o.z = pk2(v[4] * g0[4], v[5] * g0[5]); o.w = pk2(v[6] * g0[6], v[7] * g0[7]);
            *(v4u*)(WT0 + (size_t)(drow0 + n) * K + k0 + 8 * c) = o;
            v4u p; p.x = pk2(v[0] * g1[0], v[1] * g1[1]); p.y = pk2(v[2] * g1[2], v[3] * g1[3]); p.z = pk2(v[4] * g1[4], v[5] * g1[5]); p.w = pk2(v[6] * g1[6], v[7] * g1[7]);
            *(v4u*)(WT1 + (size_t)(drow0 + n) * K + k0 + 8 * c) = p;
        } else {
            v4u o; o.x = pk2(v[0], v[1]); o.y = pk2(v[2], v[3]); o.z = pk2(v[4], v[5]); o.w = pk2(v[6], v[7]);
            *(v4u*)(WT0 + (size_t)(drow0 + n) * K + k0 + 8 * c) = o; } }
    asm volatile("s_waitcnt lgkmcnt(0)" ::: "memory");
}
__device__ __forceinline__ void phase_weights(const Params& P, int l, unsigned char* lds) {
    const int tid = opaque_tid(), lane = tid & 63, wave = tid >> 6;
    float* scr = (float*)(lds + wave * 16384);
    unsigned char* Wb = P.ws + WS_W;
    const float* mod = (const float*)(P.ws + WS_MOD);
    Fold Fi, Fg, Fn{}; Fi.m0 = mod + (size_t)l * 12 * DM; Fi.m1 = Fi.m0 + 6 * DM; Fi.g = l ? P.ln2_g + (l - 1) * DM : nullptr; Fi.b = nullptr; Fi.sc = 1 * DM; Fi.sh = 0;
    Fg = Fi; Fg.g = P.ln1_g + l * DM; Fg.sc = 4 * DM; Fg.sh = 3 * DM;
    Fold Fo = Fi, Fd = Fi; Fo.sc = 2 * DM; Fd.sc = 5 * DM;
    constexpr int I_IN = 16 * 160, I_A = 8 * 32, I_B = 4 * 32, I_O = 16 * 32, I_G = 16 * 88, I_D = 44 * 32;
    constexpr int NITEMS = I_IN + I_A + I_B + I_O + 2 * I_G + I_D;
    const int gw = blockIdx.x * NWAVES + wave, NGW = gridDim.x * NWAVES;
    for (int it = gw; it < NITEMS; it += NGW) {
        int r = it;
        if (r < I_IN) { transpose_item<1>(P.w_in + (size_t)l * DM * INW, DM, INW, (bf16*)(Wb + W_IN), (bf16*)(Wb + W_IN1), Fi, 0, scr, r, lane); continue; } r -= I_IN;
        if (r < I_G) { transpose_item<1>(P.w_gate + (size_t)l * DM * DFF, DM, DFF, (bf16*)(Wb + W_GU), (bf16*)(Wb + W_GU1), Fg, 1, scr, r, lane); continue; } r -= I_G;
        if (r < I_G) { transpose_item<1>(P.w_up + (size_t)l * DM * DFF, DM, DFF, (bf16*)(Wb + W_GU), (bf16*)(Wb + W_GU1), Fg, 2, scr, r, lane); continue; } r -= I_G;
        if (r < I_A) { transpose_item<0>(P.w_a + (size_t)l * 512 * DM, 512, DM, (bf16*)(Wb + W_A), nullptr, Fn, 0, scr, r, lane); continue; } r -= I_A;
        if (r < I_B) { transpose_item<0>(P.w_b + (size_t)l * 256 * DM, 256, DM, (bf16*)(Wb + W_B), nullptr, Fn, 0, scr, r, lane); continue; } r -= I_B;
        if (r < I_O) { transpose_item<2>(P.w_o + (size_t)l * DM * DM, DM, DM, (bf16*)(Wb + W_O), (bf16*)(P.ws + WS_W2 + W2_O1), Fo, 0, scr, r, lane); continue; } r -= I_O;
        transpose_item<2>(P.w_down + (size_t)l * DFF * DM, DFF, DM, (bf16*)(Wb + W_D), (bf16*)(P.ws + WS_W2 + W2_D1), Fd, 0, scr, r, lane);
    }
}

__device__ __forceinline__ void phase_x2bf16(const float* src, bf16* dst) {
    const int n4 = NTOK * DM / 4, nth = gridDim.x * NTHREADS;
    for (int i = blockIdx.x * NTHREADS + opaque_tid(); i < n4 / 2; i += nth) { const f32x4 a = ((const f32x4*)src)[2 * i], c = ((const f32x4*)src)[2 * i + 1]; v4u w; w.x = pk_f16(a.x, a.y); w.y = pk_f16(a.z, a.w); w.z = pk_f16(c.x, c.y); w.w = pk_f16(c.z, c.w); ((v4u*)dst)[i] = w; }
}

template <bool DO_LN, bool WRITE_X, bool WRITE_U>
__device__ __forceinline__ void phase_rows(const float* src, float* xdst, bf16* udst, const float* gamma, const float* beta, const float* modl, int sc_off, int sh_off) {
    const int tid = opaque_tid(), lane = tid & 63, wave = tid >> 6;
    const int gw = blockIdx.x * NWAVES + wave, NGW = gridDim.x * NWAVES;
    for (int m = gw; m < NTOK; m += NGW) {
        const f32x4* xr = (const f32x4*)(src + (size_t)m * DM) + lane;
        f32x4 v[4];
#pragma unroll
        for (int j = 0; j < 4; ++j) v[j] = xr[64 * j];
        if (DO_LN) {
            float s = 0.f;
#pragma unroll
            for (int j = 0; j < 4; ++j) s += (v[j].x + v[j].y) + (v[j].z + v[j].w);
            const float mean = wave_sum(s) * (1.f / DM); float s2 = 0.f;
#pragma unroll
            for (int j = 0; j < 4; ++j) { v[j] = v[j] - mean; s2 += (v[j].x * v[j].x + v[j].y * v[j].y) + (v[j].z * v[j].z + v[j].w * v[j].w); }
            const float rstd = 1.f / sqrtf(wave_sum(s2) * (1.f / DM) + LN_EPS);
#pragma unroll
            for (int j = 0; j < 4; ++j) { const f32x4 g = ((const f32x4*)gamma)[lane + 64 * j], b = ((const f32x4*)beta)[lane + 64 * j]; v[j] = v[j] * rstd * g + b; }
        }
        if (WRITE_X) { f32x4* xo = (f32x4*)(xdst + (size_t)m * DM) + lane;
#pragma unroll
            for (int j = 0; j < 4; ++j) xo[64 * j] = v[j]; }
        if (WRITE_U) { const float* mb = modl + (m >= SEQ ? 6 * DM : 0); v2u* uo = (v2u*)(udst + (size_t)m * DM) + lane;
#pragma unroll
            for (int j = 0; j < 4; ++j) { const f32x4 sc = ((const f32x4*)(mb + sc_off))[lane + 64 * j], sh = ((const f32x4*)(mb + sh_off))[lane + 64 * j];
                const f32x4 uu = v[j] * (sc + 1.0f) + sh; v2u w; w.x = cvt_pk_bf16(uu.x, uu.y); w.y = cvt_pk_bf16(uu.z, uu.w); uo[64 * j] = w; } }
    }
}

__device__ __forceinline__ void phase_final_ln(const bf16* zh, float* out, const float* gamma, const float* beta) {
    const int tid = opaque_tid(), lane = tid & 63, wave = tid >> 6;
    const int gw = blockIdx.x * NWAVES + wave, NGW = gridDim.x * NWAVES;
    for (int m = gw; m < NTOK; m += NGW) {
        const v4u* hr = (const v4u*)(zh + (size_t)m * DM) + lane;
        f32x4 v[4]; float s = 0.f;
#pragma unroll
        for (int j = 0; j < 2; ++j) { const v4u h = hr[64 * j];
            v[2 * j] = (f32x4){h_lo(h.x), h_hi(h.x), h_lo(h.y), h_hi(h.y)}; v[2 * j + 1] = (f32x4){h_lo(h.z), h_hi(h.z), h_lo(h.w), h_hi(h.w)}; }
#pragma unroll
        for (int j = 0; j < 4; ++j) s += (v[j].x + v[j].y) + (v[j].z + v[j].w);
        const float mean = wave_sum(s) * (1.f / DM); float s2 = 0.f;
#pragma unroll
        for (int j = 0; j < 4; ++j) { v[j] = v[j] - mean; s2 += (v[j].x * v[j].x + v[j].y * v[j].y) + (v[j].z * v[j].z + v[j].w * v[j].w); }
        const float rstd = 1.f / sqrtf(wave_sum(s2) * (1.f / DM) + LN_EPS);
        f32x4* xo = (f32x4*)(out + (size_t)m * DM);
#pragma unroll
        for (int j = 0; j < 4; ++j) { const int e4 = (j >> 1) * 128 + 2 * lane + (j & 1);
            const f32x4 g = ((const f32x4*)gamma)[e4], b = ((const f32x4*)beta)[e4]; xo[e4] = v[j] * rstd * g + b; }
    }
}

constexpr int KV_STRIDE = 144;
constexpr int KV_ROWS = 384;
constexpr int LDS_K = 0, LDS_V = KV_ROWS * KV_STRIDE;
__device__ __forceinline__ v4i16_t tr_read(const LAS unsigned char* p) { return __builtin_amdgcn_ds_read_tr16_b64_v4i16((LAS v4i16_t*)p); }

struct AttnU { int b, d, r, n0, nrows, kcol, vcol, qcol, q0, sidx, maxdist, opitch, ocol, lse_idx; int is_a; };
__device__ __forceinline__ AttnU attn_decode(int u, int wave) {
    AttnU A;
    if (u < 1536) {
        const int blk = u & 63, t = u >> 6; A.b = t / 12; const int g = (t % 12) >> 2, j = t & 3;
        A.d = 1 << (2 * g); const int nblk = 64 >> (2 * g); A.r = blk / nblk; A.n0 = (blk % nblk) * 256; A.nrows = 384;
        A.kcol = KB_OFF + g * 256 + j * 64; A.vcol = VB_OFF + g * 256 + j * 64; A.qcol = QB_OFF + g * 256 + j * 64; A.q0 = A.n0 + 32 * wave;
        A.sidx = 8 + 4 * g + j; A.maxdist = 128; A.opitch = 768; A.ocol = g * 256 + j * 64; A.lse_idx = g * 4 + j; A.is_a = 0;
    } else {
        const int ua = u - 1536, blk = ua & 255, t = ua >> 8; A.b = t >> 1; const int kvh = t & 1; A.d = 1; A.r = 0; A.n0 = blk * 64; A.nrows = 192;
        A.kcol = KA_OFF + kvh * 64; A.vcol = VA_OFF + kvh * 64; const int head = kvh * 4 + (wave >> 1); A.qcol = QA_OFF + head * 64; A.q0 = A.n0 + 32 * (wave & 1);
        A.sidx = head; A.maxdist = 127; A.opitch = 512; A.ocol = head * 64; A.lse_idx = -1; A.is_a = 1;
    }
    return A;
}
__device__ __forceinline__ void attn_prefetch(const AttnU& A, const bf16* QKVG, int tid, int r32, int hi, v4u (&kr)[6], v4u (&vr)[6], bf16x8 (&qf)[4]) {
    { const size_t qtok = (size_t)A.b * SEQ + A.r + (size_t)A.d * (A.q0 + r32); const bf16* qp = QKVG + qtok * QKVW + A.qcol + 8 * hi;
#pragma unroll
      for (int d0 = 0; d0 < 4; ++d0) qf[d0] = *(const bf16x8*)(qp + 16 * d0); }
#pragma unroll
    for (int it = 0; it < 6; ++it) { const int c = tid + it * NTHREADS; const int R = c >> 3, ch = c & 7; const int kn = A.n0 - 128 + R;
        kr[it] = (v4u){0u, 0u, 0u, 0u}; vr[it] = (v4u){0u, 0u, 0u, 0u};
        if (R < A.nrows && kn >= 0) { const bf16* src = QKVG + ((size_t)A.b * SEQ + A.r + (size_t)A.d * kn) * QKVW + 8 * ch; kr[it] = *(const v4u*)(src + A.kcol); vr[it] = *(const v4u*)(src + A.vcol); } }
}
#define ATT_BAR() do { asm volatile("s_waitcnt lgkmcnt(0)" ::: "memory"); __builtin_amdgcn_s_barrier(); asm volatile("" ::: "memory"); } while (0)
__device__ __forceinline__ void phase_attention(const Params& P, int layer, LAS unsigned char* lds) {
    const int tid = opaque_tid(), lane = tid & 63, wave = __builtin_amdgcn_readfirstlane(tid >> 6), r32 = lane & 31, hi = lane >> 5;
    const bf16* QKVG = (const bf16*)(P.ws + WS_QKV);
    bf16* OG = (bf16*)(P.ws + WS_OG);
    bf16* YA = (bf16*)(P.ws + WS_YA);
    float* LSE = (float*)(P.ws + WS_LSE);
    const int G = gridDim.x;
    const float sink_lane = P.sinks[layer * 8 + (lane & 7)];
    v4u kr[6], vr[6]; bf16x8 qn[4];
    AttnU N = attn_decode(blockIdx.x, wave);
    if ((int)blockIdx.x < 2560) attn_prefetch(N, QKVG, tid, r32, hi, kr, vr, qn);
    for (int u = blockIdx.x; u < 2560; u += G) {
        const AttnU A = N;
        bf16x8 qf[4];
#pragma unroll
        for (int d0 = 0; d0 < 4; ++d0) qf[d0] = qn[d0];
#pragma unroll
        for (int it = 0; it < 6; ++it) { const int c = tid + it * NTHREADS; const int R = c >> 3, ch = c & 7;
            if (R < A.nrows) { *(LAS v4u*)(lds + LDS_K + R * KV_STRIDE + 16 * ch) = kr[it]; *(LAS v4u*)(lds + LDS_V + R * KV_STRIDE + 16 * ch) = vr[it]; } }
        ATT_BAR();
        if (u + G < 2560) { N = attn_decode(u + G, wave); attn_prefetch(N, QKVG, tid, r32, hi, kr, vr, qn); }
        const int b = A.b, d = A.d, r = A.r, n0 = A.n0, q0 = A.q0, maxdist = A.maxdist, lse_idx = A.lse_idx;
        const float m_init = A.is_a ? __uint_as_float(__builtin_amdgcn_readlane(__float_as_uint(sink_lane), A.sidx & 7)) * LOG2E : -1e30f, l_init = (A.is_a && hi == 0) ? 1.f : 0.f;
        bf16* obase = A.is_a ? YA : OG; const int opitch = A.opitch, ocol = A.ocol;
        const float slope2 = exp2f(-8.0f * (float)(A.sidx + 1) / 20.0f) * (float)d * LOG2E;
        float m = m_init, l = l_init; f32x16 o0, o1;
#pragma unroll
        for (int i = 0; i < 16; ++i) { o0[i] = 0.f; o1[i] = 0.f; }
        const int rowb = q0 - n0;
        const int kappa = (r32 & ~12) | ((r32 & 4) << 1) | ((r32 & 8) >> 1);
        const LAS unsigned char* kbase = lds + LDS_K + (rowb + kappa) * KV_STRIDE + 16 * hi;
        const LAS unsigned char* vbase = lds + LDS_V + (rowb + 8 * hi + ((lane & 15) >> 2)) * KV_STRIDE + (16 * ((lane >> 4) & 1) + 4 * (lane & 3)) * 2;
#pragma unroll 1
        for (int jt = 0; jt < 5; ++jt) {
            f32x16 S;
#pragma unroll
            for (int i = 0; i < 16; ++i) S[i] = 0.f;
            __builtin_amdgcn_s_setprio(1);
#pragma unroll
            for (int d0 = 0; d0 < 4; ++d0) { const bf16x8 kf = *(const LAS bf16x8*)(kbase + jt * 32 * KV_STRIDE + 32 * d0); S = __builtin_amdgcn_mfma_f32_32x32x16_bf16(kf, qf[d0], S, 0, 0, 0); }
            __builtin_amdgcn_s_setprio(0);
            const int dist0 = r32 + 128 - 32 * jt - 8 * hi, kn0 = q0 - 128 + 32 * jt + 8 * hi;
            float mx = -INFINITY;
            if (jt == 0 || jt == 4 || q0 - 128 + 32 * jt < 0) {
#pragma unroll
                for (int i = 0; i < 16; ++i) { const int off = (i & 7) + 16 * (i >> 3); const int dist = dist0 - off, key = kn0 + off;
                    const bool valid = (dist >= 0) && (dist <= maxdist) && (key >= 0);
                    S[i] = valid ? (S[i] - slope2 * (float)dist) : -INFINITY; mx = fmaxf(mx, S[i]); }
            } else {
                const float base = -slope2 * (float)dist0;
#pragma unroll
                for (int i = 0; i < 16; ++i) { const float off = (float)((i & 7) + 16 * (i >> 3)); S[i] = (S[i] + base) + slope2 * off; mx = fmaxf(mx, S[i]); }
            }
            mx = fmaxf(mx, __shfl_xor(mx, 32));
            const float mn = fmaxf(m, mx), alpha = __builtin_amdgcn_exp2f(m - mn); m = mn;
            float ls = 0.f;
#pragma unroll
            for (int i = 0; i < 16; ++i) { S[i] = __builtin_amdgcn_exp2f(S[i] - mn); ls += S[i]; }
            l = l * alpha + ls;
#pragma unroll
            for (int i = 0; i < 16; ++i) { o0[i] *= alpha; o1[i] *= alpha; }
            bf16x8 pf[2];
#pragma unroll
            for (int s = 0; s < 2; ++s) { v4u w; w.x = cvt_pk_bf16(S[8 * s + 0], S[8 * s + 1]); w.y = cvt_pk_bf16(S[8 * s + 2], S[8 * s + 3]); w.z = cvt_pk_bf16(S[8 * s + 4], S[8 * s + 5]); w.w = cvt_pk_bf16(S[8 * s + 6], S[8 * s + 7]);
                pf[s] = __builtin_bit_cast(bf16x8, w); }
#pragma unroll
            for (int s = 0; s < 2; ++s) {
                const LAS unsigned char* vp = vbase + (jt * 32 + 16 * s) * KV_STRIDE;
                const v4i16_t a0 = tr_read(vp), a1 = tr_read(vp + 4 * KV_STRIDE), b0 = tr_read(vp + 64), b1 = tr_read(vp + 4 * KV_STRIDE + 64);
                const bf16x8 vf0 = (bf16x8){a0[0], a0[1], a0[2], a0[3], a1[0], a1[1], a1[2], a1[3]};
                const bf16x8 vf1 = (bf16x8){b0[0], b0[1], b0[2], b0[3], b1[0], b1[1], b1[2], b1[3]};
                __builtin_amdgcn_s_setprio(1);
                o0 = __builtin_amdgcn_mfma_f32_32x32x16_bf16(vf0, pf[s], o0, 0, 0, 0);
                o1 = __builtin_amdgcn_mfma_f32_32x32x16_bf16(vf1, pf[s], o1, 0, 0, 0);
                __builtin_amdgcn_s_setprio(0);
            }
        }
        l += __shfl_xor(l, 32);
        const float inv = 1.0f / l;
        { const size_t otok = (size_t)b * SEQ + r + (size_t)d * (q0 + r32); bf16* op = obase + otok * opitch + ocol + 4 * hi;
#pragma unroll
          for (int g4 = 0; g4 < 4; ++g4) {
              v2u w0, w1; w0.x = cvt_pk_bf16(o0[4 * g4] * inv, o0[4 * g4 + 1] * inv); w0.y = cvt_pk_bf16(o0[4 * g4 + 2] * inv, o0[4 * g4 + 3] * inv);
              w1.x = cvt_pk_bf16(o1[4 * g4] * inv, o1[4 * g4 + 1] * inv); w1.y = cvt_pk_bf16(o1[4 * g4 + 2] * inv, o1[4 * g4 + 3] * inv);
              *(v2u*)(op + 8 * g4) = w0; *(v2u*)(op + 32 + 8 * g4) = w1; }
          if (lse_idx >= 0 && hi == 0) LSE[otok * 12 + lse_idx] = m + __builtin_amdgcn_logf(l); }
        ATT_BAR();
    }
}

#undef ATT_BAR
__device__ __forceinline__ void phase_combine(const Params& P) {
    const bf16* OG = (const bf16*)(P.ws + WS_OG); bf16* YB = (bf16*)(P.ws + WS_YB); const float* LSE = (const float*)(P.ws + WS_LSE);
    const int nth = gridDim.x * NTHREADS;
    for (int idx = blockIdx.x * NTHREADS + opaque_tid(); idx < NTOK * 32; idx += nth) {
        const int tok = idx >> 5, ch = idx & 31, j = ch >> 3;
        const float l0 = LSE[(size_t)tok * 12 + j], l1 = LSE[(size_t)tok * 12 + 4 + j], l2 = LSE[(size_t)tok * 12 + 8 + j];
        const float M = fmaxf(l0, fmaxf(l1, l2));
        float w0 = __builtin_amdgcn_exp2f(l0 - M), w1 = __builtin_amdgcn_exp2f(l1 - M), w2 = __builtin_amdgcn_exp2f(l2 - M);
        const float inv = 1.0f / (w0 + w1 + w2); w0 *= inv; w1 *= inv; w2 *= inv;
        const bf16* op = OG + (size_t)tok * 768 + ch * 8;
        const v4u a = *(const v4u*)op, b = *(const v4u*)(op + 256), c = *(const v4u*)(op + 512);
        v4u o;
        o.x = cvt_pk_bf16(w0 * bf_lo(a.x) + w1 * bf_lo(b.x) + w2 * bf_lo(c.x), w0 * bf_hi(a.x) + w1 * bf_hi(b.x) + w2 * bf_hi(c.x));
        o.y = cvt_pk_bf16(w0 * bf_lo(a.y) + w1 * bf_lo(b.y) + w2 * bf_lo(c.y), w0 * bf_hi(a.y) + w1 * bf_hi(b.y) + w2 * bf_hi(c.y));
        o.z = cvt_pk_bf16(w0 * bf_lo(a.z) + w1 * bf_lo(b.z) + w2 * bf_lo(c.z), w0 * bf_hi(a.z) + w1 * bf_hi(b.z) + w2 * bf_hi(c.z));
        o.w = cvt_pk_bf16(w0 * bf_lo(a.w) + w1 * bf_lo(b.w) + w2 * bf_lo(c.w), w0 * bf_hi(a.w) + w1 * bf_hi(b.w) + w2 * bf_hi(c.w));
        *(v4u*)(YB + (size_t)tok * 256 + ch * 8) = o;
    }
}

template <bool LN> __device__ __forceinline__ pg8::PanelSlots stage_row_stats(const pg8::StaticOrder& S, const float* stat, LAS unsigned char* L) {
    int p0 = -1, p1 = -1, p2 = -1, p3 = -1, ns = 0;
    pg8::Unit u;
    for (int i = 0; S.next(i, u); ++i) { const int pm = u.pm; if (pm == p0 || pm == p1 || pm == p2 || pm == p3) continue;
        p3 = (ns == 3) ? pm : p3; p2 = (ns == 2) ? pm : p2; p1 = (ns == 1) ? pm : p1; p0 = (ns == 0) ? pm : p0; ++ns; }
    pg8::PanelSlots ps; ps.pm0 = p0; ps.pm1 = p1; ps.pm2 = p2; ps.pm3 = p3;
    if (LN) {
        const int tid = opaque_tid();
        for (int idx = tid; idx < ns * 256; idx += NTHREADS) { const int sl = idx >> 8, r = idx & 255; const int pm = sl == 0 ? ps.pm0 : (sl == 1 ? ps.pm1 : (sl == 2 ? ps.pm2 : ps.pm3));
            const f32x4* p = (const f32x4*)(stat + ((size_t)pm * 256 + r) * 32); float sm = 0.f, q = 0.f;
#pragma unroll
            for (int j = 0; j < 8; ++j) { const f32x4 a = p[j]; sm += a[0] + a[2]; q += a[1] + a[3]; }
            const float mean = sm * (1.0f / 1024.0f), var = q * (1.0f / 1024.0f) - mean * mean, rstd = __builtin_amdgcn_rsqf(var + 1e-5f);
            typedef float f32x2v __attribute__((ext_vector_type(2)));
            *(LAS f32x2v*)(L + pg8::EPI_TAB + idx * 8) = (f32x2v){rstd, -rstd * mean}; }
        __syncthreads();
    }
    return ps;
}

template <int l> __device__ __forceinline__ void layer_body(const Params& P, const XcdBarrier& bar, unsigned char* lds, LAS unsigned char* L, int G, int bid) {
    unsigned char* ws = P.ws;
    const float* modl = (const float*)(ws + WS_MOD) + (size_t)l * 2 * 6 * DM;
    const float* vecl = (const float*)(ws + WS_VEC) + (size_t)l * VEC_LAYER;
    bf16* ZB = (bf16*)(ws + WS_ZB); bf16* YA = (bf16*)(ws + WS_YA); bf16* YB = (bf16*)(ws + WS_YB); bf16* QKV = (bf16*)(ws + WS_QKV); bf16* GATES = (bf16*)P.out; bf16* ZLO = (bf16*)(ws + WS_ZLO);
    bf16* MERGED = QKV; bf16* H = QKV;
    float* STAT1 = (float*)(ws + WS_STAT1); float* STAT2 = (float*)(ws + WS_STAT2);
    { pg8::Gemm g{ZB, (const bf16*)(ws + WS_W + W_IN), NTOK, INW, DM, (const bf16*)(ws + WS_W + W_IN1), 64}; pg8::StaticOrder S; S.init(NTOK, INW, G, bid);
      const pg8::PanelSlots ps = stage_row_stats<(l > 0)>(S, STAT2, L);
      pg8::EpiIn<(l > 0)> E{QKV, GATES, QSCALE, ps.pm0, ps.pm1, ps.pm2, ps.pm3, vecl + V_CS_IN, vecl + V_BI_IN};
      pg8::gemm_phase<pg8::EpiIn<(l > 0)>, pg8::StaticOrder, true, true, true>(L, g, S, E); }
    xcd_barrier(bar);
    phase_attention(P, l, L);
    xcd_barrier(bar);
    phase_combine(P);
    xcd_barrier(bar);
    { const bf16* w = (const bf16*)(ws + WS_W + W_A); pg8::Gemm g{YA, w, NTOK, DM, 512, w, 1 << 30}; pg8::StaticOrder S; S.init(NTOK, DM, G, bid);
      pg8::EpiGate<false> E{MERGED, GATES, 0};
      pg8::gemm_phase<pg8::EpiGate<false>, pg8::StaticOrder, true, true>(L, g, S, E); }
    { const bf16* w = (const bf16*)(ws + WS_W + W_B); pg8::Gemm g{YB, w, NTOK, DM, 256, w, 1 << 30}; pg8::StaticOrder S; S.init(NTOK, DM, G, bid);
      pg8::EpiGate<true> E{MERGED, GATES, 1024};
      pg8::gemm_phase<pg8::EpiGate<true>, pg8::StaticOrder, true, true>(L, g, S, E); }
    xcd_barrier(bar);
    { pg8::Gemm g{MERGED, (const bf16*)(ws + WS_W + W_O), NTOK, DM, DM, (const bf16*)(ws + WS_W2 + W2_O1), 64}; pg8::StaticOrder S; S.init(NTOK, DM, G, bid);
      pg8::EpiRes<(l > 0)> E{P.x, ZB, STAT2, STAT1, P.ln2_g + (l > 0 ? l - 1 : 0) * DM, P.ln2_b + (l > 0 ? l - 1 : 0) * DM, DN_ALPHA};
      pg8::gemm_phase<pg8::EpiRes<(l > 0)>, pg8::StaticOrder, true, true>(L, g, S, E); }
    xcd_barrier(bar);
    { pg8::Gemm g{ZB, (const bf16*)(ws + WS_W + W_GU), NTOK, NGU, DM, (const bf16*)(ws + WS_W + W_GU1), 64}; pg8::StaticOrder S; S.init(NTOK, NGU, G, bid);
      const pg8::PanelSlots ps = stage_row_stats<true>(S, STAT1, L);
      pg8::EpiSwiGLU E{H, ps.pm0, ps.pm1, ps.pm2, ps.pm3, vecl + V_CS_GU, vecl + V_BI_GU};
      pg8::gemm_phase<pg8::EpiSwiGLU, pg8::StaticOrder, true, true, true>(L, g, S, E); }
    xcd_barrier(bar);
    { pg8::Gemm g{H, (const bf16*)(ws + WS_W + W_D), NTOK, DM, DFF, (const bf16*)(ws + WS_W2 + W2_D1), 64}; pg8::StaticOrder S; S.init(NTOK, DM, G, bid);
      pg8::EpiRes<true> E{P.x, ZB, STAT1, STAT2, P.ln1_g + l * DM, P.ln1_b + l * DM, DN_ALPHA};
      pg8::gemm_phase<pg8::EpiRes<true>, pg8::StaticOrder, true, true>(L, g, S, E); }
    xcd_barrier(bar);
    if (l + 1 < DEPTH) { phase_weights(P, l + 1, lds); xcd_barrier(bar); }
    else phase_final_ln(ZB, P.out, P.ln2_g + l * DM, P.ln2_b + l * DM);
}

__global__ void __launch_bounds__(NTHREADS, 2) fwd_megakernel(Params P) {
    extern __shared__ __attribute__((aligned(16))) unsigned char lds[];
    cg::grid_group grid = cg::this_grid();
    LAS unsigned char* L = (LAS unsigned char*)lds;
    const int G = gridDim.x, bid = blockIdx.x;
    unsigned char* ws = P.ws;
    unsigned* barw = (unsigned*)(ws + WS_BAR);
    if (bid == 0) for (int i = threadIdx.x; i < XCD_BAR_WORDS; i += NTHREADS) __hip_atomic_store(barw + i, 0u, __ATOMIC_RELAXED, __HIP_MEMORY_SCOPE_AGENT);
    volatile LAS unsigned* MISC = (volatile LAS unsigned*)(L + MISC_OFF);
    if (threadIdx.x < 32) MISC[threadIdx.x] = 0u;
    __syncthreads();
    phase_mods(P, lds);
    phase_x2bf16(P.x, (bf16*)(ws + WS_ZB));
    grid.sync();
    const XcdBarrier bar = xcd_barrier_post(barw, MISC + 8);
    phase_vecs(P, lds);
    phase_weights(P, 0, lds);
    xcd_barrier(bar);
    layer_body<0>(P, bar, lds, L, G, bid);
    layer_body<1>(P, bar, lds, L, G, bid);
    layer_body<2>(P, bar, lds, L, G, bid);
    layer_body<3>(P, bar, lds, L, G, bid);
}

extern "C" void kernel_launch(void* const* d_in, const int* in_sizes, int n_in, void* d_out, int out_size, void* d_ws, size_t ws_size, hipStream_t stream) {
    static int grid = 0;
    if (grid == 0) {
        if (n_in != 16 || in_sizes[0] != NTOK * DM || out_size != NTOK * DM || ws_size < WS_END) { fprintf(stderr, "kernel_launch: unexpected shapes (n_in %d, in0 %d, out %d, ws %zu)\n", n_in, n_in > 0 ? in_sizes[0] : -1, out_size, ws_size); grid = -1; return; }
        int dev = 0, cus = 0, per_cu = 0;
        hipGetDevice(&dev); hipDeviceGetAttribute(&cus, hipDeviceAttributeMultiprocessorCount, dev);
        hipFuncSetAttribute((const void*)fwd_megakernel, hipFuncAttributeMaxDynamicSharedMemorySize, LDS_BYTES);
        hipOccupancyMaxActiveBlocksPerMultiprocessor(&per_cu, (const void*)fwd_megakernel, NTHREADS, LDS_BYTES);
        (void)hipGetLastError();
        if (per_cu < 1) { fprintf(stderr, "kernel_launch: occupancy query says %d blocks per CU\n", per_cu); per_cu = 1; }
        grid = cus;
    }
    if (grid < 0) return;
    Params p{};
    p.x = (const float*)d_in[0]; p.c = (const float*)d_in[1]; p.w_ada = (const float*)d_in[2]; p.b_ada = (const float*)d_in[3]; p.w_in = (const float*)d_in[4]; p.sinks = (const float*)d_in[5];
    p.w_a = (const float*)d_in[6]; p.w_b = (const float*)d_in[7]; p.w_o = (const float*)d_in[8]; p.ln1_g = (const float*)d_in[9]; p.ln1_b = (const float*)d_in[10];
    p.w_gate = (const float*)d_in[11]; p.w_up = (const float*)d_in[12]; p.w_down = (const float*)d_in[13]; p.ln2_g = (const float*)d_in[14]; p.ln2_b = (const float*)d_in[15];
    p.out = (float*)d_out; p.ws = (unsigned char*)d_ws;
    void* args[] = {&p};
    hipError_t e = hipLaunchCooperativeKernel((const void*)fwd_megakernel, dim3(grid), dim3(NTHREADS), args, LDS_BYTES, stream);
    if (e != hipSuccess) fprintf(stderr, "kernel_launch: cooperative launch failed: %s (grid %d)\n", hipGetErrorString(e), grid);
}
```
